# Optimizing an MI355X kernel written in HIP

```python
import math
import jax
import jax.numpy as jnp
from jax import lax
import numpy as np

D_MODEL = 1024
BATCH = 8
SEQ = 8192
DEPTH = 2

CTX_LEN = 256
GRID_W = 64
N_HEADS = 8
N_KV_HEADS = 2
HEAD_DIM = 64
Q_PER_KV = N_HEADS // N_KV_HEADS
W_ATTN = N_HEADS * HEAD_DIM
W_KV = N_KV_HEADS * HEAD_DIM
WINDOW = 128
BLOCK = 128
ROPE_BASE = 10000.0
W_S5 = 256
S5_GROUP = 16
S5_GROUPS = W_S5 // S5_GROUP
S5_STATE = 64
DT_MIN = 0.001
DT_MAX = 0.1
ML_HEADS = 4
ML_HEAD_DIM = 64
W_ML = ML_HEADS * ML_HEAD_DIM
ML_CHUNK = 64
N_BRANCH = 3
D_FF = 2816
CONV_W = 3
NORM_EPS = 1e-6
IN_SPLITS = (W_ATTN, W_KV, W_KV, W_S5, W_ML, W_ML, W_ML, W_ML, 4 * ML_HEADS, N_BRANCH * D_MODEL)
D_IN = W_ATTN + 2 * W_KV + W_S5 + 4 * W_ML + 4 * ML_HEADS + N_BRANCH * D_MODEL

kernel_name = 'hybrid_prefix_swa_s5_mlstm_block'


def _rmsnorm(x, g):
    x32 = x.astype(jnp.float32)
    y = x32 * lax.rsqrt(jnp.mean(x32 * x32, axis=-1, keepdims=True) + NORM_EPS)
    return (y * g.astype(jnp.float32)).astype(x.dtype)


def _modulate(h, shift, scale):
    return h * (1 + scale) + shift


def _split_in(z):
    offsets, run = [], 0
    for size in IN_SPLITS[:-1]:
        run += size
        offsets.append(run)
    return jnp.split(z, offsets, axis=-1)


def _axial_angles(n_tok):
    rows = n_tok // GRID_W
    row = jnp.broadcast_to(jnp.arange(rows, dtype=jnp.float32)[:, None], (rows, GRID_W)).reshape(-1)
    col = jnp.broadcast_to(jnp.arange(GRID_W, dtype=jnp.float32)[None, :], (rows, GRID_W)).reshape(-1)
    n_freq = HEAD_DIM // 4
    inv_freq = ROPE_BASE ** (-jnp.arange(n_freq, dtype=jnp.float32) / n_freq)
    return row[:, None] * inv_freq[None, :], col[:, None] * inv_freq[None, :]


def _rotate(u, ang):
    half = u.shape[-1] // 2
    cos = jnp.cos(ang)[None, :, None, :].astype(u.dtype)
    sin = jnp.sin(ang)[None, :, None, :].astype(u.dtype)
    u1, u2 = u[..., :half], u[..., half:]
    return jnp.concatenate([u1 * cos - u2 * sin, u2 * cos + u1 * sin], axis=-1)


def _axial_rope(t, ang_row, ang_col):
    half = HEAD_DIM // 2
    return jnp.concatenate([_rotate(t[..., :half], ang_row), _rotate(t[..., half:], ang_col)], axis=-1)


def _attn_latent(q, k, v, kc, vc, sink):
    b, n_tok = q.shape[0], q.shape[1]
    nb = n_tok // BLOCK
    scale = HEAD_DIM ** -0.5
    pad = ((0, 0), (BLOCK, BLOCK), (0, 0), (0, 0))
    kp, vp = jnp.pad(k, pad), jnp.pad(v, pad)
    qb = jnp.moveaxis(q.reshape(b, nb, BLOCK, N_KV_HEADS, Q_PER_KV, HEAD_DIM), 1, 0)
    sink_col = jnp.broadcast_to(sink[None, :, :, None, None], (b, N_KV_HEADS, Q_PER_KV, BLOCK, 1))
    offs_q = jnp.arange(BLOCK)
    offs_k = jnp.arange(3 * BLOCK) - BLOCK

    def one_block(args):
        qj, j = args
        start = j * BLOCK
        kj = lax.dynamic_slice_in_dim(kp, start, 3 * BLOCK, axis=1)
        vj = lax.dynamic_slice_in_dim(vp, start, 3 * BLOCK, axis=1)
        qpos = start + offs_q
        kpos = start + offs_k
        valid = (jnp.abs(qpos[:, None] - kpos[None, :]) <= WINDOW) & (kpos >= 0)[None, :] & (kpos < n_tok)[None, :]
        s_loc = jnp.einsum('bqhgd,bkhd->bhgqk', qj, kj).astype(jnp.float32) * scale
        s_loc = jnp.where(valid, s_loc, -jnp.inf)
        s_ctx = jnp.einsum('bqhgd,bchd->bhgqc', qj, kc).astype(jnp.float32) * scale
        p = jax.nn.softmax(jnp.concatenate([s_loc, s_ctx, sink_col], axis=-1), axis=-1).astype(v.dtype)
        return (jnp.einsum('bhgqk,bkhd->bqhgd', p[..., :3 * BLOCK], vj)
                + jnp.einsum('bhgqc,bchd->bqhgd', p[..., 3 * BLOCK:-1], vc))

    out = lax.map(one_block, (qb, jnp.arange(nb)))
    return jnp.moveaxis(out, 0, 1).reshape(b, n_tok, W_ATTN)


def _attn_context(qc, kc, vc, sink):
    b, n_ctx = qc.shape[0], qc.shape[1]
    s = jnp.einsum('bqhgd,bchd->bhgqc', qc, kc).astype(jnp.float32) * HEAD_DIM ** -0.5
    sink_col = jnp.broadcast_to(sink[None, :, :, None, None], (b, N_KV_HEADS, Q_PER_KV, n_ctx, 1))
    p = jax.nn.softmax(jnp.concatenate([s, sink_col], axis=-1), axis=-1).astype(vc.dtype)
    return jnp.einsum('bhgqc,bchd->bqhgd', p[..., :-1], vc).reshape(b, n_ctx, W_ATTN)


def _cmul(ar, ai, br, bi):
    return ar * br - ai * bi, ar * bi + ai * br


def _s5_scan(bu_re, bu_im, lam_re, lam_im, dre, dim, init=None):
    n_t = bu_re.shape[1]
    a_re = jnp.broadcast_to(lam_re, (1, n_t) + lam_re.shape)
    a_im = jnp.broadcast_to(lam_im, (1, n_t) + lam_im.shape)

    def combine(e1, e2):
        a1r, a1i, b1r, b1i = e1
        a2r, a2i, b2r, b2i = e2
        ar, ai = _cmul(a2r, a2i, a1r, a1i)
        br, bi = _cmul(a2r, a2i, b1r, b1i)
        return ar, ai, br + b2r, bi + b2i

    _, _, s_re, s_im = lax.associative_scan(combine, (a_re, a_im, bu_re, bu_im), axis=1)
    if init is not None:
        steps = jnp.arange(1, n_t + 1, dtype=jnp.float32)[:, None, None]
        pmag = jnp.exp(steps * dre)
        p_re, p_im = pmag * jnp.cos(steps * dim), pmag * jnp.sin(steps * dim)
        i_re, i_im = _cmul(p_re[None], p_im[None], init[0][:, None], init[1][:, None])
        s_re, s_im = s_re + i_re, s_im + i_im
    return s_re, s_im


def _s5_direction(ux, uc, a_re, a_im, log_dt, b_re, b_im, reverse):
    dt = jnp.exp(log_dt)[:, None]
    dre, dim = dt * a_re, dt * a_im
    mag = jnp.exp(dre)
    lam_re, lam_im = mag * jnp.cos(dim), mag * jnp.sin(dim)
    den = a_re * a_re + a_im * a_im
    coef_re = ((lam_re - 1.0) * a_re + lam_im * a_im) / den
    coef_im = (lam_im * a_re - (lam_re - 1.0) * a_im) / den
    bb_re, bb_im = _cmul(coef_re[..., None], coef_im[..., None], b_re, b_im)

    def drive(u):
        br = jnp.einsum('btgc,gpc->btgp', u, bb_re)
        bi = jnp.einsum('btgc,gpc->btgp', u, bb_im)
        return (jnp.flip(br, 1), jnp.flip(bi, 1)) if reverse else (br, bi)

    sc_re, sc_im = _s5_scan(*drive(uc), lam_re, lam_im, dre, dim)
    sx_re, sx_im = _s5_scan(*drive(ux), lam_re, lam_im, dre, dim, init=(sc_re[:, -1], sc_im[:, -1]))
    if reverse:
        sx_re, sx_im, sc_re, sc_im = (jnp.flip(a, 1) for a in (sx_re, sx_im, sc_re, sc_im))
    return sx_re, sx_im, sc_re, sc_im


def _s5_branch(ux, uc, a_re, a_im, log_dt, b_re, b_im, c_re, c_im, d_skip, glu_w, glu_b, with_ctx):
    f32 = jnp.float32

    def grouped(u):
        b, t, _ = u.shape
        return u.astype(f32).reshape(b, t, S5_GROUPS, S5_GROUP)

    gx, gc = grouped(ux), grouped(uc)
    a_re, a_im, log_dt, b_re, b_im, c_re, c_im = (p.astype(f32) for p in (a_re, a_im, log_dt, b_re, b_im, c_re, c_im))
    fwd = _s5_direction(gx, gc, a_re[0], a_im[0], log_dt[0], b_re, b_im, False)
    bwd = _s5_direction(gx, gc, a_re[1], a_im[1], log_dt[1], b_re, b_im, True)
    dsk = d_skip.astype(f32).reshape(S5_GROUPS, S5_GROUP)
    w_glu, b_glu = glu_w.astype(f32), glu_b.astype(f32)

    def readout(s_re, s_im, u, like):
        b, t = u.shape[0], u.shape[1]
        y = (jnp.einsum('btgp,gcp->btgc', s_re, c_re) - jnp.einsum('btgp,gcp->btgc', s_im, c_im)
             + dsk * u)
        y = jax.nn.gelu(y.reshape(b, t, W_S5))
        return (y * jax.nn.sigmoid(y @ w_glu + b_glu)).astype(like.dtype)

    y_lat = readout(fwd[0] + bwd[0], fwd[1] + bwd[1], gx, ux)
    y_ctx = readout(fwd[2] + bwd[2], fwd[3] + bwd[3], gc, uc) if with_ctx else None
    return y_lat, y_ctx


def _mlstm_scan(q, k, v, ig, lf, state):
    b, h, t, _ = q.shape
    nc = t // ML_CHUNK

    def chunks(a):
        return jnp.moveaxis(a.reshape((b, h, nc, ML_CHUNK) + a.shape[3:]), 2, 0)

    tril = jnp.tril(jnp.ones((ML_CHUNK, ML_CHUNK), dtype=bool))

    def step(carry, inp):
        c_mat, n_vec, m = carry
        qc, kc, vc, ic, fc = inp
        bcum = jnp.cumsum(fc, axis=-1)
        a_inter = bcum + m[..., None]
        d_intra = jnp.where(tril, bcum[..., :, None] - bcum[..., None, :] + ic[..., None, :], -jnp.inf)
        m_t = jnp.maximum(a_inter, jnp.max(d_intra, axis=-1))
        w_inter = jnp.exp(a_inter - m_t)
        w_intra = jnp.exp(d_intra - m_t[..., None]) * jnp.einsum('bhtd,bhsd->bhts', qc, kc)
        num = (w_inter[..., None] * jnp.einsum('bhed,bhtd->bhte', c_mat, qc)
               + jnp.einsum('bhts,bhse->bhte', w_intra, vc))
        den = w_inter * jnp.einsum('bhd,bhtd->bht', n_vec, qc) + jnp.sum(w_intra, axis=-1)
        h_out = num / jnp.maximum(jnp.abs(den), jnp.exp(-m_t))[..., None]
        b_end = bcum[..., -1]
        g = b_end[..., None] - bcum + ic
        m_new = jnp.maximum(b_end + m, jnp.max(g, axis=-1))
        decay = jnp.exp(b_end + m - m_new)
        w_s = jnp.exp(g - m_new[..., None])
        c_new = decay[..., None, None] * c_mat + jnp.einsum('bhs,bhse,bhsd->bhed', w_s, vc, kc)
        n_new = decay[..., None] * n_vec + jnp.einsum('bhs,bhsd->bhd', w_s, kc)
        return (c_new, n_new, m_new), h_out

    final, hs = lax.scan(step, state, (chunks(q), chunks(k), chunks(v), chunks(ig), chunks(lf)))
    return jnp.moveaxis(hs, 0, 2).reshape(b, h, t, v.shape[-1]), final


def _mlstm_branch(qx, kx, vx, ox, gx, qc, kc, vc, oc, gc, ig_b, fg_b, norm_g, with_ctx):
    f32 = jnp.float32
    k_scale = ML_HEAD_DIM ** -0.5

    def heads(a):
        b, t, _ = a.shape
        return a.astype(f32).reshape(b, t, ML_HEADS, ML_HEAD_DIM).transpose(0, 2, 1, 3)

    def gate_preacts(g):
        b, t, _ = g.shape
        return g.astype(f32).reshape(b, t, 4, ML_HEADS).transpose(2, 0, 3, 1)

    lat = (heads(qx), heads(kx) * k_scale, heads(vx))
    ctxs = (heads(qc), heads(kc) * k_scale, heads(vc))
    g_lat, g_ctx = gate_preacts(gx), gate_preacts(gc)
    ig_b, fg_b = ig_b.astype(f32), fg_b.astype(f32)
    b = qx.shape[0]
    zero = (jnp.zeros((b, ML_HEADS, ML_HEAD_DIM, ML_HEAD_DIM), f32),
            jnp.zeros((b, ML_HEADS, ML_HEAD_DIM), f32),
            jnp.zeros((b, ML_HEADS), f32))
    h_lat, h_ctx = [], []
    for d in range(2):
        def prep(qkv, g):
            ig = g[2 * d] + ig_b[d][:, None]
            lf = jax.nn.log_sigmoid(g[2 * d + 1] + fg_b[d][:, None])
            arrs = (qkv[0], qkv[1], qkv[2], ig, lf)
            return tuple(jnp.flip(a, 2) for a in arrs) if d == 1 else arrs
        hc_d, state = _mlstm_scan(*prep(ctxs, g_ctx), zero)
        hx_d, _ = _mlstm_scan(*prep(lat, g_lat), state)
        if d == 1:
            hc_d, hx_d = jnp.flip(hc_d, 2), jnp.flip(hx_d, 2)
        h_lat.append(hx_d)
        h_ctx.append(hc_d)

    def readout(h, o):
        h = h * lax.rsqrt(jnp.mean(h * h, axis=-1, keepdims=True) + NORM_EPS)
        bb, _, t, _ = h.shape
        h = h.transpose(0, 2, 1, 3).reshape(bb, t, W_ML) * norm_g.astype(f32)
        return (h * jax.nn.sigmoid(o.astype(f32))).astype(o.dtype)

    y_lat = readout(h_lat[0] + h_lat[1], ox)
    y_ctx = readout(h_ctx[0] + h_ctx[1], oc) if with_ctx else None
    return y_lat, y_ctx


def _token_mixers(hx, hc, ang_row, ang_col, w_in, attn_sink, s5_a_re, s5_a_im, s5_log_dt, s5_b_re, s5_b_im,
                  s5_c_re, s5_c_im, s5_d, s5_glu_w, s5_glu_b, ml_igate_b, ml_fgate_b, ml_norm_g,
                  w_branch_attn, w_branch_s5, w_branch_ml, w_out, with_ctx):
    b, n_tok, _ = hx.shape
    n_ctx = hc.shape[1]
    qa_x, ka_x, va_x, us_x, qm_x, km_x, vm_x, om_x, gm_x, gb_x = _split_in(hx @ w_in)
    qa_c, ka_c, va_c, us_c, qm_c, km_c, vm_c, om_c, gm_c, gb_c = _split_in(hc @ w_in)
    q_lat = _axial_rope(qa_x.reshape(b, n_tok, N_HEADS, HEAD_DIM), ang_row, ang_col)
    q_lat = q_lat.reshape(b, n_tok, N_KV_HEADS, Q_PER_KV, HEAD_DIM)
    k_lat = _axial_rope(ka_x.reshape(b, n_tok, N_KV_HEADS, HEAD_DIM), ang_row, ang_col)
    v_lat = va_x.reshape(b, n_tok, N_KV_HEADS, HEAD_DIM)
    k_ctx = ka_c.reshape(b, n_ctx, N_KV_HEADS, HEAD_DIM)
    v_ctx = va_c.reshape(b, n_ctx, N_KV_HEADS, HEAD_DIM)
    sink = attn_sink.astype(jnp.float32).reshape(N_KV_HEADS, Q_PER_KV)
    ya_x = _attn_latent(q_lat, k_lat, v_lat, k_ctx, v_ctx, sink)
    ys_x, ys_c = _s5_branch(us_x, us_c, s5_a_re, s5_a_im, s5_log_dt, s5_b_re, s5_b_im, s5_c_re, s5_c_im,
                            s5_d, s5_glu_w, s5_glu_b, with_ctx)
    ym_x, ym_c = _mlstm_branch(qm_x, km_x, vm_x, om_x, gm_x, qm_c, km_c, vm_c, om_c, gm_c,
                               ml_igate_b, ml_fgate_b, ml_norm_g, with_ctx)

    def merge(ya, ys, ym, gates):
        g_a, g_s, g_m = jnp.split(gates, N_BRANCH, axis=-1)
        y = (jax.nn.sigmoid(g_a) * (ya @ w_branch_attn) + jax.nn.sigmoid(g_s) * (ys @ w_branch_s5)
             + jax.nn.sigmoid(g_m) * (ym @ w_branch_ml))
        return y @ w_out

    out_x = merge(ya_x, ys_x, ym_x, gb_x)
    if not with_ctx:
        return out_x, None
    q_ctx = qa_c.reshape(b, n_ctx, N_KV_HEADS, Q_PER_KV, HEAD_DIM)
    ya_c = _attn_context(q_ctx, k_ctx, v_ctx, sink)
    return out_x, merge(ya_c, ys_c, ym_c, gb_c)


def _conv_ffn(h, w_up, conv_w, conv_b, w_down):
    u = h @ w_up
    up = jnp.pad(u, ((0, 0), (1, 1), (0, 0)))
    u = up[:, :-2] * conv_w[0] + up[:, 1:-1] * conv_w[1] + up[:, 2:] * conv_w[2] + conv_b
    a, v = jnp.split(u, 2, axis=-1)
    return (jax.nn.silu(a) * v) @ w_down


def setup_inputs(seed: int = 0) -> dict:
    key = jax.random.key(seed)
    ks = iter(jax.random.split(key, 40))
    f32 = jnp.float32

    def nrm(shape, scale):
        return scale * jax.random.normal(next(ks), shape, f32)

    L, D = DEPTH, D_MODEL
    inp = {}
    inp['x'] = nrm((BATCH, SEQ, D), 1.0)
    inp['c'] = nrm((BATCH, D), 1.0)
    inp['ctx'] = nrm((BATCH, CTX_LEN, D), 1.0)
    inp['c_ctx'] = nrm((D,), 1.0)
    inp['mod_w'] = nrm((L, D, 6 * D), D ** -0.5)
    inp['mod_b'] = nrm((L, 6 * D), 0.02)
    inp['norm1_g'] = 1.0 + nrm((L, D), 0.02)
    inp['norm2_g'] = 1.0 + nrm((L, D), 0.02)
    inp['w_in'] = nrm((L, D, D_IN), D ** -0.5)
    inp['attn_sink'] = nrm((L, N_HEADS), 0.5)
    inp['s5_a_re'] = -0.5 + nrm((L, 2, S5_GROUPS, S5_STATE), 0.01)
    inp['s5_a_im'] = math.pi * jnp.arange(S5_STATE, dtype=f32) + nrm((L, 2, S5_GROUPS, S5_STATE), 0.01)
    inp['s5_log_dt'] = jax.random.uniform(next(ks), (L, 2, S5_GROUPS), f32, math.log(DT_MIN), math.log(DT_MAX))
    inp['s5_b_re'] = nrm((L, S5_GROUPS, S5_STATE, S5_GROUP), (2 * S5_GROUP) ** -0.5)
    inp['s5_b_im'] = nrm((L, S5_GROUPS, S5_STATE, S5_GROUP), (2 * S5_GROUP) ** -0.5)
    inp['s5_c_re'] = nrm((L, S5_GROUPS, S5_GROUP, S5_STATE), S5_STATE ** -0.5)
    inp['s5_c_im'] = nrm((L, S5_GROUPS, S5_GROUP, S5_STATE), S5_STATE ** -0.5)
    inp['s5_d'] = nrm((L, W_S5), 1.0)
    inp['s5_glu_w'] = nrm((L, W_S5, W_S5), W_S5 ** -0.5)
    inp['s5_glu_b'] = nrm((L, W_S5), 0.02)
    inp['ml_igate_b'] = nrm((L, 2, ML_HEADS), 0.1)
    inp['ml_fgate_b'] = jnp.linspace(3.0, 6.0, ML_HEADS, dtype=f32) + nrm((L, 2, ML_HEADS), 0.1)
    inp['ml_norm_g'] = 1.0 + nrm((L, W_ML), 0.02)
    inp['w_branch_attn'] = nrm((L, W_ATTN, D), W_ATTN ** -0.5)
    inp['w_branch_s5'] = nrm((L, W_S5, D), W_S5 ** -0.5)
    inp['w_branch_ml'] = nrm((L, W_ML, D), W_ML ** -0.5)
    inp['w_out'] = nrm((L, D, D), D ** -0.5)
    inp['ffn_w_up'] = nrm((L, D, 2 * D_FF), D ** -0.5)
    inp['ffn_conv_w'] = nrm((L, CONV_W, 2 * D_FF), CONV_W ** -0.5)
    inp['ffn_conv_b'] = nrm((L, 2 * D_FF), 0.02)
    inp['ffn_w_down'] = nrm((L, D_FF, D), D_FF ** -0.5)
    inp['final_norm_g'] = 1.0 + nrm((D,), 0.02)
    return inp


def reference(x, c, ctx, c_ctx, mod_w, mod_b, norm1_g, norm2_g, w_in, attn_sink, s5_a_re, s5_a_im, s5_log_dt,
              s5_b_re, s5_b_im, s5_c_re, s5_c_im, s5_d, s5_glu_w, s5_glu_b, ml_igate_b, ml_fgate_b, ml_norm_g,
              w_branch_attn, w_branch_s5, w_branch_ml, w_out, ffn_w_up, ffn_conv_w, ffn_conv_b, ffn_w_down,
              final_norm_g):
    ang_row, ang_col = _axial_angles(x.shape[1])
    xc = ctx
    for layer in range(DEPTH):
        with_ctx = layer < DEPTH - 1
        mod_x = (jax.nn.silu(c) @ mod_w[layer] + mod_b[layer])[:, None, :]
        mod_c = jax.nn.silu(c_ctx) @ mod_w[layer] + mod_b[layer]
        sh1x, sc1x, g1x, sh2x, sc2x, g2x = jnp.split(mod_x, 6, axis=-1)
        sh1c, sc1c, g1c, sh2c, sc2c, g2c = jnp.split(mod_c, 6, axis=-1)
        hx = _modulate(_rmsnorm(x, norm1_g[layer]), sh1x, sc1x)
        hc = _modulate(_rmsnorm(xc, norm1_g[layer]), sh1c, sc1c)
        mx, mc = _token_mixers(hx, hc, ang_row, ang_col, w_in[layer], attn_sink[layer], s5_a_re[layer],
                               s5_a_im[layer], s5_log_dt[layer], s5_b_re[layer], s5_b_im[layer], s5_c_re[layer],
                               s5_c_im[layer], s5_d[layer], s5_glu_w[layer], s5_glu_b[layer], ml_igate_b[layer],
                               ml_fgate_b[layer], ml_norm_g[layer], w_branch_attn[layer], w_branch_s5[layer],
                               w_branch_ml[layer], w_out[layer], with_ctx)
        x = x + g1x * mx
        x = x + g2x * _conv_ffn(_modulate(_rmsnorm(x, norm2_g[layer]), sh2x, sc2x), ffn_w_up[layer],
                                ffn_conv_w[layer], ffn_conv_b[layer], ffn_w_down[layer])
        if with_ctx:
            xc = xc + g1c * mc
            xc = xc + g2c * _conv_ffn(_modulate(_rmsnorm(xc, norm2_g[layer]), sh2c, sc2c), ffn_w_up[layer],
                                      ffn_conv_w[layer], ffn_conv_b[layer], ffn_w_down[layer])
    return _rmsnorm(x, final_norm_g)
```

```cpp
#include <hip/hip_runtime.h>
#include <cstdio>
#include <cstdint>
#include <type_traits>
namespace pg8 {
#define PG8_LAS __attribute__((address_space(3)))
typedef unsigned short bf16_t;
typedef short bf16x8 __attribute__((ext_vector_type(8)));
typedef float f32x4 __attribute__((ext_vector_type(4)));
typedef unsigned u32x4 __attribute__((ext_vector_type(4)));
constexpr int BM = 256, BK = 64, HALF = 128, HTB = HALF * BK * 2  , STAGE_BYTES = 8 * HTB, NXCD = 8, WGM = 4;

__host__ __device__ __forceinline__ int lds_byte(int r, int c) { const int st = (r >> 4) * 2 + (c >> 5), rr = r & 15, cc = c & 31, ob = rr * 64 + cc * 2; return st * 1024 + (ob ^ (((ob >> 9) & 1) << 5)); }
__host__ __device__ __forceinline__ void stage_rc(int b, int& R, int& C) { const int st = b / 1024, sb = b % 1024, swz = sb ^ (((sb >> 9) & 1) << 5); R = (st >> 1) * 16 + swz / 64; C = (st & 1) * 32 + (swz % 64) / 2; }
__host__ __device__ __forceinline__ int perm32(int rho) { const int n = rho >> 4, i = rho & 15; return 8 * (i >> 2) + 4 * n + (i & 3); }

struct Unit { int pm, pn, seq; };
struct Gemm { const bf16_t* A; const bf16_t* Bt; int M, N, K, lda, ldb; };

struct StaticOrder {
    int nM, nN, nwg, G, c;
    __host__ __device__ void init(int M, int N, int G_, int c_) { nM = M / BM; nN = N / BM; nwg = nM * nN; G = G_; c = c_; }
    __host__ __device__ bool next(int i, Unit& u) const {
        const long L = (long)i * G + c; if (L >= nwg) return false;
        int wgid = (int)L; { const int q = nwg / NXCD, r = nwg % NXCD, xcd = wgid % NXCD, off = wgid / NXCD; wgid = (xcd < r ? xcd * (q + 1) : r * (q + 1) + (xcd - r) * q) + off; }
        const int nig = WGM * nN, gid = wgid / nig, fm = gid * WGM, gsz = WGM;
        u.pm = fm + ((wgid % nig) % gsz); u.pn = (wgid % nig) / gsz; u.seq = i; return true;
    }
    __device__ __forceinline__ void a_ready(const Unit&) const {}
    __device__ __forceinline__ void done(const Unit&) const {}
};


struct NoState {};
template <class T, class = void> struct epi_state { typedef NoState type; static constexpr bool has = false; };
template <class T> struct epi_state<T, std::void_t<typename T::State>> { typedef typename T::State type; static constexpr bool has = true; };
template <class T, class = void> struct epi_nseg { static constexpr int value = 1; };
template <class T> struct epi_nseg<T, std::void_t<typename T::State>> { static constexpr int value = T::NSEG; };
template <class Epi, class Sched, bool ALIGN_EPI = false, bool SP2 = false, bool NHALF = false>
__device__ __forceinline__ void gemm_phase(PG8_LAS unsigned char* lds, const Gemm g, const Sched& S, const Epi& E) {
    int tid_ = threadIdx.x; asm volatile("" : "+v"(tid_));
    const int tid = tid_, wid = __builtin_amdgcn_readfirstlane(tid >> 6), lane = tid & 63, wr = wid >> 2, wc = wid & 3, fr = lane & 15, fq = lane >> 4;
    const int K = g.K, nt = K / BK;
    unsigned voffA[2], voffB[2];
#pragma unroll
    for (int i = 0; i < 2; ++i) { int R, C; stage_rc(tid * 16 + i * 8192, R, C); const int Rb = Epi::PERM ? ((R & ~31) + perm32(R & 31)) : R;
        voffA[i] = (unsigned)(R * g.lda + C) * 2u; voffB[i] = (unsigned)(Rb * g.ldb + C) * 2u; }
    const size_t kstep = (size_t)(BK * 2);
    const size_t hstepA = (size_t)HALF * g.lda * 2, hstepB = (size_t)HALF * g.ldb * 2;
    const size_t tstepA = 2 * hstepA, tstepB = 2 * hstepB;
    const size_t bstep = NHALF ? hstepB : tstepB, bh = NHALF ? 0 : hstepB;
    static_assert(!NHALF || SP2, "NHALF is implemented for the SP2 loop");
    const unsigned ldsw = (unsigned)wid * 1024u;
    const int aoff = lds_byte(wr * 64 + fr, fq * 8), boff = lds_byte(wc * 32 + fr, fq * 8);
#define PG8_SA(b, h) (((b) * 2 + (h)) * HTB)
#define PG8_SB(b, h) ((4 + (b) * 2 + (h)) * HTB)
#define PG8_STAGE(bufoff, gbase, voff) do { _Pragma("unroll") for (int _i = 0; _i < 2; ++_i) \
        __builtin_amdgcn_global_load_lds((const unsigned*)((const char*)(gbase) + (voff)[_i]), (PG8_LAS unsigned*)(lds + (bufoff) + ldsw + _i * 8192), 16, 0, 0); } while (0)
#define PG8_STAGE_NT(bufoff, gbase, voff) do { _Pragma("unroll") for (int _i = 0; _i < 2; ++_i) \
        __builtin_amdgcn_global_load_lds((const unsigned*)((const char*)(gbase) + (voff)[_i]), (PG8_LAS unsigned*)(lds + (bufoff) + ldsw + _i * 8192), 16, 0, 0); } while (0)
#define PG8_LDA(dst, b, h) do { _Pragma("unroll") for (int m = 0; m < 4; ++m) _Pragma("unroll") for (int k = 0; k < 2; ++k) dst[m][k] = *(const PG8_LAS bf16x8*)(lds + PG8_SA(b, h) + aoff + m * 2048 + k * 1024); } while (0)
#define PG8_LDB(dst, b, h) do { _Pragma("unroll") for (int n = 0; n < 2; ++n) _Pragma("unroll") for (int k = 0; k < 2; ++k) dst[n][k] = *(const PG8_LAS bf16x8*)(lds + PG8_SB(b, h) + boff + n * 2048 + k * 1024); } while (0)
#define PG8_MMA(ai, bj, At, Bt) do { __builtin_amdgcn_s_setprio(1); _Pragma("unroll") for (int m = 0; m < 4; ++m) _Pragma("unroll") for (int n = 0; n < 2; ++n) _Pragma("unroll") for (int k = 0; k < 2; ++k) \
        acc[ai][bj][m][n] = __builtin_amdgcn_mfma_f32_16x16x32_bf16(Bt[n][k], At[m][k], acc[ai][bj][m][n], 0, 0, 0); __builtin_amdgcn_s_setprio(0); } while (0)
#define PG8_WAIT_V(n) asm volatile("s_waitcnt vmcnt(" #n ")" ::: "memory")
#define PG8_WAIT_L(n) asm volatile("s_waitcnt lgkmcnt(" #n ")" ::: "memory")
#define PG8_BAR __builtin_amdgcn_s_barrier()
#define PG8_SCHED __builtin_amdgcn_sched_barrier(0)
    Unit cur, nxt; int ui = 0;
    if (!S.next(0, cur)) return;
    f32x4 acc[2][2][4][2];
    typename epi_state<Epi>::type est;
#pragma unroll
    for (int a = 0; a < 2; ++a)
#pragma unroll
        for (int b = 0; b < 2; ++b)
#pragma unroll
            for (int m = 0; m < 4; ++m)
#pragma unroll
                for (int n = 0; n < 2; ++n) acc[a][b][m][n] = (f32x4){0.f, 0.f, 0.f, 0.f};
    bf16x8 At[4][2], B0[2][2], B1[2][2];
    const char* cA = (const char*)g.A + (size_t)cur.pm * tstepA; const char* cB = (const char*)g.Bt + (size_t)cur.pn * bstep;
    S.a_ready(cur);
    if constexpr (SP2) {
        PG8_STAGE_NT(PG8_SB(0, 0), cB, voffB); PG8_STAGE_NT(PG8_SB(0, 1), cB + bh, voffB); PG8_STAGE(PG8_SA(0, 0), cA, voffA); PG8_STAGE(PG8_SA(0, 1), cA + hstepA, voffA);
        if (wr == 1) PG8_BAR;
        PG8_WAIT_V(2); PG8_BAR;
        PG8_STAGE_NT(PG8_SB(1, 0), cB + kstep, voffB); PG8_STAGE(PG8_SA(1, 0), cA + kstep, voffA); PG8_STAGE_NT(PG8_SB(1, 1), cB + bh + kstep, voffB);
        PG8_WAIT_V(6); PG8_BAR;
    } else {
        PG8_STAGE_NT(PG8_SB(0, 0), cB, voffB); PG8_STAGE(PG8_SA(0, 0), cA, voffA); PG8_STAGE_NT(PG8_SB(0, 1), cB + bh, voffB); PG8_STAGE(PG8_SA(0, 1), cA + hstepA, voffA);
        if (wr == 1) PG8_BAR;
        PG8_WAIT_V(4); PG8_BAR;
        PG8_STAGE_NT(PG8_SB(1, 0), cB + kstep, voffB); PG8_STAGE(PG8_SA(1, 0), cA + kstep, voffA); PG8_STAGE_NT(PG8_SB(1, 1), cB + bh + kstep, voffB);
        PG8_WAIT_V(6); PG8_BAR;
    }
    for (;;) {
        const bool has_next = S.next(ui + 1, nxt);
        const char* nA = has_next ? (const char*)g.A + (size_t)nxt.pm * tstepA : cA; const char* nB = has_next ? (const char*)g.Bt + (size_t)nxt.pn * bstep : cB;
        int t = 0;
        constexpr int NSEG = epi_nseg<Epi>::value;
        if constexpr (epi_state<Epi>::has) E.init(est);
        for (int seg = 0; seg < NSEG; ++seg) {
        int tend = nt; if constexpr (epi_state<Epi>::has) { tend = E.seg_end(seg); E.seg_open(seg, est, cur, wr, wc, fr, fq); }
#pragma nounroll
        for (; t < tend; t += 2) {
            const bool last = (t == nt - 2);
            const char* a1 = cA + (size_t)(t + 1) * kstep;
            const char* a2 = last ? nA : cA + (size_t)(t + 2) * kstep; const char* b2 = last ? nB : cB + (size_t)(t + 2) * kstep;
            const char* a3 = a2 + kstep; const char* b3 = b2 + kstep;
            if (last && has_next) S.a_ready(nxt);
            if constexpr (SP2) {
            PG8_LDB(B0, 0, 0); if constexpr (!NHALF) PG8_LDB(B1, 0, 1); PG8_SCHED; PG8_LDA(At, 0, 0); PG8_STAGE(PG8_SA(1, 1), a1 + hstepA, voffA);
            PG8_WAIT_V(8); PG8_WAIT_L(0); PG8_BAR; PG8_MMA(0, 0, At, B0); if constexpr (!NHALF) PG8_MMA(0, 1, At, B1); PG8_BAR; PG8_SCHED;
            PG8_LDA(At, 0, 1); PG8_STAGE_NT(PG8_SB(0, 0), b2, voffB); PG8_STAGE_NT(PG8_SB(0, 1), b2 + bh, voffB); PG8_STAGE(PG8_SA(0, 0), a2, voffA);
            PG8_WAIT_V(8); PG8_WAIT_L(0); PG8_BAR; PG8_MMA(1, 0, At, B0); if constexpr (!NHALF) PG8_MMA(1, 1, At, B1); PG8_BAR; PG8_SCHED;
            PG8_LDB(B0, 1, 0); if constexpr (!NHALF) PG8_LDB(B1, 1, 1); PG8_SCHED; PG8_LDA(At, 1, 0); PG8_STAGE(PG8_SA(0, 1), a2 + hstepA, voffA);
            PG8_WAIT_V(8); PG8_WAIT_L(0); PG8_BAR; PG8_MMA(0, 0, At, B0); if constexpr (!NHALF) PG8_MMA(0, 1, At, B1); PG8_BAR; PG8_SCHED;
            PG8_LDA(At, 1, 1); PG8_STAGE_NT(PG8_SB(1, 0), b3, voffB); PG8_STAGE_NT(PG8_SB(1, 1), b3 + bh, voffB); PG8_STAGE(PG8_SA(1, 0), a3, voffA);
            PG8_WAIT_V(8); PG8_WAIT_L(0); PG8_BAR; PG8_MMA(1, 0, At, B0); if constexpr (!NHALF) PG8_MMA(1, 1, At, B1); PG8_BAR; PG8_SCHED;
            } else {
            PG8_LDB(B0, 0, 0); PG8_SCHED; PG8_LDA(At, 0, 0); PG8_STAGE(PG8_SA(1, 1), a1 + hstepA, voffA);
            PG8_WAIT_L(8); PG8_BAR; PG8_WAIT_L(0); PG8_MMA(0, 0, At, B0); PG8_BAR; PG8_SCHED;
            PG8_LDB(B1, 0, 1); PG8_STAGE_NT(PG8_SB(0, 0), b2, voffB);
            PG8_BAR; PG8_WAIT_L(0); PG8_MMA(0, 1, At, B1); PG8_BAR;
            PG8_LDA(At, 0, 1); PG8_STAGE(PG8_SA(0, 0), a2, voffA);
            PG8_BAR; PG8_WAIT_L(0); PG8_MMA(1, 0, At, B0); PG8_BAR; PG8_SCHED;
            PG8_STAGE_NT(PG8_SB(0, 1), b2 + bh, voffB);
            PG8_WAIT_V(6); PG8_BAR; PG8_MMA(1, 1, At, B1); PG8_BAR;
            PG8_LDB(B0, 1, 0); PG8_SCHED; PG8_LDA(At, 1, 0); PG8_STAGE(PG8_SA(0, 1), a2 + hstepA, voffA);
            PG8_WAIT_L(8); PG8_BAR; PG8_WAIT_L(0); PG8_MMA(0, 0, At, B0); PG8_BAR; PG8_SCHED;
            PG8_LDB(B1, 1, 1); PG8_STAGE_NT(PG8_SB(1, 0), b3, voffB);
            PG8_BAR; PG8_WAIT_L(0); PG8_MMA(0, 1, At, B1); PG8_BAR;
            PG8_LDA(At, 1, 1); PG8_STAGE(PG8_SA(1, 0), a3, voffA);
            PG8_BAR; PG8_WAIT_L(0); PG8_MMA(1, 0, At, B0); PG8_BAR; PG8_SCHED;
            PG8_STAGE_NT(PG8_SB(1, 1), b3 + bh, voffB);
            PG8_WAIT_V(6); PG8_BAR; PG8_MMA(1, 1, At, B1); PG8_BAR;
            }
        }
        if constexpr (epi_state<Epi>::has) E.seg_close(seg, acc, est);
        }
        if constexpr (ALIGN_EPI) { if (wr == 0) PG8_BAR; }
        if constexpr (!Epi::AFTER_DRAIN) { if constexpr (epi_state<Epi>::has) E.finish(acc, est, cur, wr, wc, fr, fq); else E(acc, cur, wr, wc, fr, fq); S.done(cur); }
        if (!has_next) break;
#pragma unroll
        for (int a = 0; a < 2; ++a)
#pragma unroll
            for (int b = 0; b < 2; ++b)
#pragma unroll
                for (int m = 0; m < 4; ++m)
#pragma unroll
                    for (int n = 0; n < 2; ++n) acc[a][b][m][n] = (f32x4){0.f, 0.f, 0.f, 0.f};
        cur = nxt; cA = nA; cB = nB; ++ui;
        if constexpr (ALIGN_EPI) { if (wr == 1) PG8_BAR; }
    }
    PG8_WAIT_V(0);
    if constexpr (!ALIGN_EPI) { if (wr == 0) PG8_BAR; }
    PG8_BAR;
    if constexpr (Epi::AFTER_DRAIN) { E.fused(acc, cur, wr, wc, fr, fq, lds, wid, lane); S.done(cur); }
#undef PG8_SA
#undef PG8_SB
#undef PG8_STAGE
#undef PG8_STAGE_NT
#undef PG8_LDA
#undef PG8_LDB
#undef PG8_MMA
#undef PG8_WAIT_V
#undef PG8_WAIT_L
#undef PG8_BAR
#undef PG8_SCHED
}
}

constexpr int NB = 8, SEQ = 8192, DM = 1024, NCTX = 256, DEPTH = 2;
constexpr int MLAT = NB * SEQ, MCTX = NB * NCTX, MTOT = MLAT + MCTX;
constexpr int NIN = 5376;
constexpr int ZP = 1792;
constexpr int DFF = 2816, NUP = 2 * DFF;
constexpr int S5T = 32, NCH5 = MTOT / S5T, NCH5P = 2304, A2P = 768;
constexpr int NCHM = MTOT / 64;
constexpr int MH1 = 32768;
constexpr float NORM_EPS = 1e-6f;

constexpr size_t al256(size_t x) { return (x + 255) & ~(size_t)255; }
constexpr size_t WS_CTL = 0, CTL_BYTES = 1u << 20;
constexpr size_t WS_SSQ  = WS_CTL + CTL_BYTES;
constexpr size_t ZERO_BYTES = 65536;
constexpr size_t WS_MODP = WS_SSQ + al256((size_t)4 * MTOT * 4);
constexpr size_t WS_MODV = WS_MODP + al256((size_t)2 * 16 * 9 * 6144 * 4);
constexpr size_t WS_ROPE = WS_MODV + al256((size_t)2 * 9 * 6144 * 4);
constexpr size_t WS_LP   = WS_ROPE + al256((size_t)128 * 16 * 2 * 4);
constexpr size_t WS_BB   = WS_LP + al256((size_t)2 * 2 * 16 * 64 * 33 * 2 * 4);
constexpr size_t WS_KD   = WS_BB + al256((size_t)2 * 2 * 16 * 64 * 16 * 2 * 4);
constexpr size_t WS_GAM  = WS_KD + al256((size_t)2 * 16 * 2 * 32 * 256 * 4);
constexpr size_t WS_SHWI = WS_GAM + al256((size_t)2 * 2 * 9 * 1024 * 4);
constexpr size_t WS_SHWU = WS_SHWI + al256((size_t)2 * 9 * NIN * 4);
constexpr size_t WS_WIN  = WS_SHWU + al256((size_t)2 * 9 * NUP * 4);
constexpr size_t WS_WBA  = WS_WIN + (size_t)2 * NIN * 1024 * 2;
constexpr size_t WS_WBS  = WS_WBA + (size_t)2 * 1024 * 512 * 2;
constexpr size_t WS_WBM  = WS_WBS + (size_t)2 * 1024 * 256 * 2;
constexpr size_t WS_WOUT = WS_WBM + (size_t)2 * 1024 * 256 * 2;
constexpr size_t WS_WUP  = WS_WOUT + (size_t)2 * 1024 * 1024 * 2;
constexpr size_t WS_WDN  = WS_WUP + (size_t)2 * NUP * 1024 * 2;
constexpr size_t WS_WGLU = WS_WDN + (size_t)2 * 1024 * DFF * 2;
constexpr size_t WS_W1   = WS_WGLU + (size_t)2 * 256 * 256 * 2;
constexpr size_t WS_W2   = WS_W1 + (size_t)2 * 16 * 256 * 512 * 2;
constexpr size_t WS_XC   = WS_W2 + (size_t)2 * 16 * 512 * 768 * 2;
constexpr size_t WS_HN   = WS_XC + (size_t)MCTX * DM * 4;
constexpr size_t WS_R    = WS_HN + (size_t)MTOT * DM * 2;
constexpr size_t WS_Z1   = WS_R;
constexpr size_t WS_A2   = WS_Z1 + (size_t)MTOT * ZP * 2;
constexpr size_t WS_GM   = WS_A2 + (size_t)16 * NCH5P * A2P * 2;
constexpr size_t WS_GATE = WS_GM + (size_t)MTOT * 16 * 4;
constexpr size_t WS_YS   = WS_GATE + (size_t)MTOT * 3072;
constexpr size_t WS_YPRE = WS_YS + (size_t)MTOT * 256 * 2;
constexpr size_t WS_E    = WS_YPRE + (size_t)MTOT * 256 * 2;
constexpr size_t WS_DC   = WS_E + (size_t)16 * NCH5P * 256 * 4;
constexpr size_t WS_CIN  = WS_DC + (size_t)NCHM * 8 * 4096 * 2;
constexpr size_t WS_DN   = WS_CIN + (size_t)NCHM * 8 * 4096 * 2;
constexpr size_t WS_NIN  = WS_DN + (size_t)NCHM * 8 * 64 * 4;
constexpr size_t WS_BEND = WS_NIN + (size_t)NCHM * 8 * 64 * 4;
constexpr size_t WS_REND = WS_BEND + al256((size_t)NCHM * 8 * 4);
constexpr size_t WS_ACT  = WS_R;
constexpr size_t WS_RAW  = WS_ACT + (size_t)MTOT * DFF * 2;
constexpr size_t WS_FEND = WS_RAW + (size_t)(MTOT / 256) * 4 * NUP * 4;
constexpr size_t WS_HN2  = WS_FEND;
static_assert(WS_HN2 + (size_t)MTOT * DM * 2 <= WS_REND, "HN2 placement");
constexpr size_t WS_END  = WS_REND > WS_FEND ? WS_REND : WS_FEND;
static_assert(WS_END <= ((size_t)1 << 30), "d_ws map exceeds 1 GiB");
static_assert(WS_Z1 % 256 == 0 && WS_A2 % 256 == 0 && WS_HN % 256 == 0 && WS_E % 256 == 0 && WS_DC % 256 == 0 && WS_RAW % 256 == 0 && WS_HN2 % 256 == 0 && WS_WIN % 256 == 0, "alignment");

constexpr int CW_BAR = 4096;

constexpr int RING_BYTES = 131072, MISC_OFF = RING_BYTES + 320, PREF_OFF = RING_BYTES + 10240, LDS_BYTES = 147456;

#define LAS __attribute__((address_space(3)))
typedef unsigned short bf16;
typedef short bf16x8 __attribute__((ext_vector_type(8)));
typedef short s16x4 __attribute__((ext_vector_type(4)));
typedef float f32x4 __attribute__((ext_vector_type(4)));
typedef float f32x16 __attribute__((ext_vector_type(16)));
typedef float f32x8 __attribute__((ext_vector_type(8)));
typedef unsigned u32x4 __attribute__((ext_vector_type(4)));
typedef unsigned u32x2 __attribute__((ext_vector_type(2)));

typedef float f32x2_t __attribute__((ext_vector_type(2))); typedef __bf16 bf16x2_t __attribute__((ext_vector_type(2)));
__device__ __forceinline__ unsigned pk2(float lo, float hi) { f32x2_t v = {lo, hi}; bf16x2_t b = __builtin_convertvector(v, bf16x2_t); return __builtin_bit_cast(unsigned, b); }
__device__ __forceinline__ float bflo(unsigned w) { return __uint_as_float(w << 16); }
__device__ __forceinline__ float bfhi(unsigned w) { return __uint_as_float(w & 0xffff0000u); }
__device__ __forceinline__ float bf2f(bf16 h) { return __uint_as_float(((unsigned)h) << 16); }
__device__ __forceinline__ bf16 f2bf(float f) { return (bf16)(pk2(f, 0.f) & 0xffffu); }
__device__ __forceinline__ float sigmoidf_(float x) { return __builtin_amdgcn_rcpf(1.0f + __expf(-x)); }
__device__ __forceinline__ float wave_sum(float v) {
#pragma unroll
    for (int o = 1; o < 64; o <<= 1) v += __shfl_xor(v, o);
    return v;
}

#define XB_TMO      128
#define XB_XCNT(j)  (256  + 64 * (j))
#define XB_XSUB(j)  (1280 + 64 * (j))
#define XB_XGEN(j)  (2304 + 64 * (j))
#define XB_TOP      3328
#define XB_TOPGEN   3392
#define XCD_BAR_WORDS 3456
#define XB_SPIN_CAP (1u << 18)
__device__ __forceinline__ unsigned xb_ld(unsigned* p)              { return __hip_atomic_load(p, __ATOMIC_RELAXED, __HIP_MEMORY_SCOPE_AGENT); }
__device__ __forceinline__ unsigned xb_add(unsigned* p, unsigned v) { return __hip_atomic_fetch_add(p, v, __ATOMIC_RELAXED, __HIP_MEMORY_SCOPE_AGENT); }
__device__ __forceinline__ unsigned xb_xcc_id() { return (unsigned)__builtin_amdgcn_s_getreg((3 << 11) | 20) & 0xFu; }
#define XB_SPIN(cond, bar) do { unsigned _sp = 0; while (cond) { __builtin_amdgcn_s_sleep(1); \
    if ((++_sp & 255u) == 0u) { if (xb_ld(&(bar)[XB_TMO])) break; if (_sp > XB_SPIN_CAP) { atomicAdd(&(bar)[XB_TMO], 1u); break; } } } } while (0)
struct XcdBarrier { unsigned* bar; unsigned x; volatile LAS unsigned* st; };
__device__ __forceinline__ XcdBarrier xcd_barrier_post(unsigned* bar, volatile LAS unsigned* st) {
    XcdBarrier b; b.bar = bar; b.x = xb_xcc_id(); b.st = st;
    if (threadIdx.x == 0) (void)xb_add(&bar[XB_XCNT(b.x)], 1u);
    return b;
}
__device__ __forceinline__ void xcd_barrier_complete(unsigned* bar, unsigned x, unsigned& nloc, unsigned& nx) {
    const unsigned G = gridDim.x * gridDim.y * gridDim.z;
    unsigned sum, cnt, mine, sp = 0u;
    for (;;) {
        sum = 0u; cnt = 0u; mine = 0u;
#pragma unroll
        for (unsigned j = 0; j < 16; ++j) { const unsigned c = xb_ld(&bar[XB_XCNT(j)]); sum += c; cnt += (c > 0u) ? 1u : 0u; mine = (j == x) ? c : mine; }
        if (sum == G) break;
        __builtin_amdgcn_s_sleep(1);
        if ((++sp & 255u) == 0u) { if (xb_ld(&bar[XB_TMO])) break; if (sp > XB_SPIN_CAP) { atomicAdd(&bar[XB_TMO], 1u); break; } }
    }
    nloc = mine > 0u ? mine : 1u; nx = cnt > 0u ? cnt : 1u;
}
__device__ __forceinline__ void xcd_barrier(const XcdBarrier& b) {
    asm volatile("s_waitcnt vmcnt(0)" ::: "memory");
    __syncthreads();
    if (threadIdx.x == 0) {
        unsigned* bar = b.bar;
        __builtin_amdgcn_s_waitcnt(0);
        unsigned nloc = b.st[0], nx = b.st[1];
        if (nloc == 0u) { xcd_barrier_complete(bar, b.x, nloc, nx); b.st[0] = nloc; b.st[1] = nx; }
        const unsigned old = xb_add(&bar[XB_XSUB(b.x)], 1u);
        const unsigned gen = old / nloc;
        if (old + 1u == (gen + 1u) * nloc) {
            __builtin_amdgcn_fence(__ATOMIC_RELEASE, "agent");
            asm volatile("s_waitcnt vmcnt(0)" ::: "memory");
            const unsigned og = xb_add(&bar[XB_TOP], 1u);
            const unsigned tg = og / nx;
            if (og + 1u == (tg + 1u) * nx) xb_add(&bar[XB_TOPGEN], 1u);
            else XB_SPIN(xb_ld(&bar[XB_TOPGEN]) == tg, bar);
            __builtin_amdgcn_fence(__ATOMIC_ACQUIRE, "agent");
            xb_add(&bar[XB_XGEN(b.x)], 1u);
            asm volatile("s_waitcnt vmcnt(0)" ::: "memory");
        } else {
            XB_SPIN(xb_ld(&bar[XB_XGEN(b.x)]) == gen, bar);
            __builtin_amdgcn_fence(__ATOMIC_ACQUIRE, "agent");
            asm volatile("s_waitcnt vmcnt(0)" ::: "memory");
        }
    }
    __syncthreads();
}

struct GroupOrder {
    int ng, mt, nt, G, c, mstride;
    __device__ __forceinline__ bool next(int i, pg8::Unit& u) const {
        const long L = (long)i * G + c; const int per = mt * nt; if (L >= (long)ng * per) return false;
        const int l = (int)L, g = l / per, r = l % per; u.pm = g * mstride + r / nt; u.pn = g * nt + r % nt; u.seq = i; return true;
    }
    __device__ __forceinline__ void a_ready(const pg8::Unit&) const {}
    __device__ __forceinline__ void done(const pg8::Unit&) const {}
};

struct RoundOrder {
    pg8::StaticOrder b; int r;
    __device__ __forceinline__ bool next(int i, pg8::Unit& u) const { return i == 0 && b.next(r, u); }
    __device__ __forceinline__ void a_ready(const pg8::Unit&) const {}
    __device__ __forceinline__ void done(const pg8::Unit&) const {}
};
struct PrefOrder : pg8::StaticOrder {
    const float* ssq; const float* shw; int ldsh; LAS float* slot;
    __device__ __forceinline__ void a_ready(const pg8::Unit& u) const {
        const int w = __builtin_amdgcn_readfirstlane(threadIdx.x >> 6), lane = threadIdx.x & 63;
        if (w < 2) { const int grow0 = u.pm * 256; const int jb = grow0 < MLAT ? (grow0 >> 13) : 8;
            const float* src = w == 0 ? ssq + grow0 + 4 * lane : shw + (size_t)jb * ldsh + u.pn * 256 + 4 * lane;
            LAS float* dst = slot + (u.seq & 1) * 512 + w * 256;
            __builtin_amdgcn_global_load_lds((const unsigned*)src, (LAS unsigned*)dst, 16, 0, 0); }
    }
};
__device__ __forceinline__ float logsig(float x) { return x >= 0.f ? -log1pf(expf(-x)) : x - log1pf(expf(x)); }
struct EpiWin {
    static constexpr bool PERM = true, AFTER_DRAIN = false;
    bf16* z1; bf16* a2; float* gm; unsigned char* gate; const LAS float* slot  ; const float* igb; const float* fgb;
    __device__ __forceinline__ void operator()(const f32x4 (&acc)[2][2][4][2], const pg8::Unit& u, int wr, int wc, int fr, int fq) const {
        const int pn = u.pn; const int row0 = u.pm * 256 + wr * 64 + fr;
        const LAS float* sl = slot + (u.seq & 1) * 512;
        f32x4 sw[2][2];
#pragma unroll
        for (int bj = 0; bj < 2; ++bj) { const LAS float* sp = sl + 256 + bj * 128 + wc * 32 + fq * 8; sw[bj][0] = *(const LAS f32x4*)sp; sw[bj][1] = *(const LAS f32x4*)(sp + 4); }
        float rsv[2][4];
#pragma unroll
        for (int ai = 0; ai < 2; ++ai)
#pragma unroll
            for (int m = 0; m < 4; ++m) rsv[ai][m] = sl[wr * 64 + fr + ai * 128 + m * 16];
#pragma unroll
        for (int ai = 0; ai < 2; ++ai)
#pragma unroll
            for (int m = 0; m < 4; ++m) rsv[ai][m] = rsqrtf(rsv[ai][m] * (1.0f / DM) + NORM_EPS);
        if (pn >= 9) {
#pragma unroll
            for (int ai = 0; ai < 2; ++ai)
#pragma unroll
                for (int m = 0; m < 4; ++m) rsv[ai][m] *= -1.4426950408889634f;
#pragma unroll
            for (int bj = 0; bj < 2; ++bj) { sw[bj][0] = sw[bj][0] * -1.4426950408889634f; sw[bj][1] = sw[bj][1] * -1.4426950408889634f; } }
#pragma unroll
        for (int ai = 0; ai < 2; ++ai)
#pragma unroll
            for (int m = 0; m < 4; ++m) { const int row = row0 + ai * 128 + m * 16;
                const float rs = rsv[ai][m];
#pragma unroll
                for (int bj = 0; bj < 2; ++bj) { const int cl = bj * 128 + wc * 32 + fq * 8; f32x4 v0 = acc[ai][bj][m][0] * rs + sw[bj][0], v1 = acc[ai][bj][m][1] * rs + sw[bj][1];
                    if (pn >= 9) {
                        u32x2 w; w.x = 0u; w.y = 0u;
#pragma unroll
                        for (int e = 0; e < 4; ++e) {
                            w.x = __builtin_amdgcn_cvt_pk_u8_f32(__builtin_floorf(__builtin_amdgcn_rcpf(1.0f + __builtin_amdgcn_exp2f(v0[e])) * 255.0f + 0.5f), e, w.x);
                            w.y = __builtin_amdgcn_cvt_pk_u8_f32(__builtin_floorf(__builtin_amdgcn_rcpf(1.0f + __builtin_amdgcn_exp2f(v1[e])) * 255.0f + 0.5f), e, w.y); }
                        *(u32x2*)(gate + (size_t)row * 3072 + (pn - 9) * 256 + cl) = w;
                    } else if (pn == 8) {
                        if (cl < 16) { float* d = gm + (size_t)row * 16 + cl;
                            const f32x4 bi = *(const f32x4*)(igb + (cl >> 3) * 4), bf = *(const f32x4*)(fgb + (cl >> 3) * 4); v0 = v0 + bi;
#pragma unroll
                            for (int e = 0; e < 4; ++e) v1[e] = logsig(v1[e] + bf[e]);
                            *(f32x4*)d = v0; *(f32x4*)(d + 4) = v1; }
                    } else {
                        if (pn == 5) { v0 = v0 * 0.125f; v1 = v1 * 0.125f; }
                        if (pn < 2) { v0 = v0 * 0.18033688011112042f; v1 = v1 * 0.18033688011112042f; }
                        u32x4 w; w.x = pk2(v0[0], v0[1]); w.y = pk2(v0[2], v0[3]); w.z = pk2(v1[0], v1[1]); w.w = pk2(v1[2], v1[3]);
                        if (pn == 3) { const int g = cl >> 4, cc = cl & 15; *(u32x4*)(a2 + ((size_t)g * NCH5P + (row >> 5)) * A2P + (row & 31) * 16 + cc) = w; }
                        else { const int col = (pn < 3 ? pn * 256 : 768 + (pn - 4) * 256) + cl; *(u32x4*)(z1 + (size_t)row * ZP + col) = w; }
                    }
                } }
    }
};
struct EpiS5E {
    static constexpr bool PERM = false, AFTER_DRAIN = false;
    float* E;
    __device__ __forceinline__ void operator()(const f32x4 (&acc)[2][2][4][2], const pg8::Unit& u, int wr, int wc, int fr, int fq) const {
        const int row0 = u.pm * 256 + wr * 64 + fr;
#pragma unroll
        for (int ai = 0; ai < 2; ++ai)
#pragma unroll
            for (int m = 0; m < 4; ++m) { const int row = row0 + ai * 128 + m * 16; if ((row % NCH5P) >= NCH5) continue;
#pragma unroll
                for (int bj = 0; bj < 2; ++bj)
#pragma unroll
                    for (int n = 0; n < 2; ++n) *(f32x4*)(E + (size_t)row * 256 + bj * 128 + wc * 32 + n * 16 + fq * 4) = acc[ai][bj][m][n]; }
    }
};
__device__ __forceinline__ float gelu_tanh(float x) { const float u = 0.7978845608028654f * (x + 0.044715f * x * x * x); const float e = __expf(2.0f * u); const float th = 1.0f - 2.0f / (e + 1.0f); return 0.5f * x * (1.0f + th); }
struct EpiS5Y {
    static constexpr bool PERM = true, AFTER_DRAIN = false;
    bf16* ypre;
    __device__ __forceinline__ void operator()(const f32x4 (&acc)[2][2][4][2], const pg8::Unit& u, int wr, int wc, int fr, int fq) const {
        const int g = u.pm / 9, jn = u.pn & 1; const int ch0 = (u.pm % 9) * 256 + wr * 64 + fr;
#pragma unroll
        for (int ai = 0; ai < 2; ++ai)
#pragma unroll
            for (int m = 0; m < 4; ++m) { const int ch = ch0 + ai * 128 + m * 16; if (ch >= NCH5) continue;
#pragma unroll
                for (int bj = 0; bj < 2; ++bj) { const int nl = jn * 256 + bj * 128 + wc * 32 + fq * 8; const int t = nl >> 4, c = nl & 15; const f32x4 v0 = acc[ai][bj][m][0], v1 = acc[ai][bj][m][1];
                    u32x4 w; w.x = pk2(gelu_tanh(v0[0]), gelu_tanh(v0[1])); w.y = pk2(gelu_tanh(v0[2]), gelu_tanh(v0[3])); w.z = pk2(gelu_tanh(v1[0]), gelu_tanh(v1[1])); w.w = pk2(gelu_tanh(v1[2]), gelu_tanh(v1[3]));
                    *(u32x4*)(ypre + ((size_t)ch * 32 + t) * 256 + g * 16 + c) = w; } asm volatile("" ::: "memory"); }
    }
};
struct EpiGlu {
    static constexpr bool PERM = true, AFTER_DRAIN = false;
    const bf16* ypre; bf16* ys; const float* bias; int ldy;
    __device__ __forceinline__ void operator()(const f32x4 (&acc)[2][2][4][2], const pg8::Unit& u, int wr, int wc, int fr, int fq) const {
        const int row0 = u.pm * 256 + wr * 64 + fr; const int colb = wc * 32 + fq * 8;
        f32x4 bs[2][2];
#pragma unroll
        for (int bj = 0; bj < 2; ++bj) { bs[bj][0] = *(const f32x4*)(bias + bj * 128 + colb); bs[bj][1] = *(const f32x4*)(bias + bj * 128 + colb + 4); }
#pragma unroll
        for (int ai = 0; ai < 2; ++ai) {
            u32x4 yv[4][2];
#pragma unroll
            for (int m = 0; m < 4; ++m)
#pragma unroll
                for (int bj = 0; bj < 2; ++bj) yv[m][bj] = *(const u32x4*)(ypre + (size_t)(row0 + ai * 128 + m * 16) * 256 + bj * 128 + colb);
#pragma unroll
            for (int m = 0; m < 4; ++m)
#pragma unroll
                for (int bj = 0; bj < 2; ++bj) { const f32x4 v0 = acc[ai][bj][m][0] + bs[bj][0], v1 = acc[ai][bj][m][1] + bs[bj][1]; const u32x4 y = yv[m][bj];
                    u32x4 w;
                    w.x = pk2(bflo(y.x) * sigmoidf_(v0[0]), bfhi(y.x) * sigmoidf_(v0[1])); w.y = pk2(bflo(y.y) * sigmoidf_(v0[2]), bfhi(y.y) * sigmoidf_(v0[3]));
                    w.z = pk2(bflo(y.z) * sigmoidf_(v1[0]), bfhi(y.z) * sigmoidf_(v1[1])); w.w = pk2(bflo(y.w) * sigmoidf_(v1[2]), bfhi(y.w) * sigmoidf_(v1[3]));
                    *(u32x4*)(ys + (size_t)(row0 + ai * 128 + m * 16) * ldy + bj * 128 + colb) = w; }
            asm volatile("" ::: "memory");
        }
    }
};
struct EpiMergeF {
    static constexpr bool PERM = true, AFTER_DRAIN = false;
    struct State { f32x4 Y[2][4][2]; u32x2 gq[2][4]; };
    bf16* y; const unsigned char* gate;
    __device__ __forceinline__ void fetch(State& st, const pg8::Unit& u, int wr, int wc, int fr, int fq, int goff) const {
        const unsigned char* gp = gate + (size_t)(u.pm * 256 + wr * 64 + fr) * 3072 + goff + u.pn * 128 + wc * 32 + fq * 8;
#pragma unroll
        for (int ai = 0; ai < 2; ++ai)
#pragma unroll
            for (int m = 0; m < 4; ++m) st.gq[ai][m] = *(const u32x2*)(gp + (size_t)(ai * 128 + m * 16) * 3072);
    }
    __device__ __forceinline__ void close(f32x4 (&acc)[2][2][4][2], State& st) const {
        const float s = 1.0f / 255.0f;
#pragma unroll
        for (int ai = 0; ai < 2; ++ai)
#pragma unroll
            for (int m = 0; m < 4; ++m) { const u32x2 g = st.gq[ai][m];
                const f32x4 g0 = {(float)(g.x & 255u) * s, (float)((g.x >> 8) & 255u) * s, (float)((g.x >> 16) & 255u) * s, (float)(g.x >> 24) * s};
                const f32x4 g1 = {(float)(g.y & 255u) * s, (float)((g.y >> 8) & 255u) * s, (float)((g.y >> 16) & 255u) * s, (float)(g.y >> 24) * s};
                st.Y[ai][m][0] += g0 * acc[ai][0][m][0]; st.Y[ai][m][1] += g1 * acc[ai][0][m][1];
                acc[ai][0][m][0] = (f32x4){0.f, 0.f, 0.f, 0.f}; acc[ai][0][m][1] = (f32x4){0.f, 0.f, 0.f, 0.f}; }
    }
    static constexpr int NSEG = 3;
    __device__ __forceinline__ int seg_end(int seg) const { return seg == 0 ? 8 : (seg == 1 ? 12 : 16); }
    __device__ __forceinline__ void init(State& st) const {
#pragma unroll
        for (int ai = 0; ai < 2; ++ai)
#pragma unroll
            for (int m = 0; m < 4; ++m) { st.Y[ai][m][0] = (f32x4){0.f, 0.f, 0.f, 0.f}; st.Y[ai][m][1] = (f32x4){0.f, 0.f, 0.f, 0.f}; st.gq[ai][m] = (u32x2){0u, 0u}; }
    }
    __device__ __forceinline__ void seg_open(int seg, State& st, const pg8::Unit& u, int wr, int wc, int fr, int fq) const { fetch(st, u, wr, wc, fr, fq, seg * 1024); }
    __device__ __forceinline__ void seg_close(int seg, f32x4 (&acc)[2][2][4][2], State& st) const { close(acc, st); }
    __device__ __forceinline__ void finish(f32x4 (&acc)[2][2][4][2], State& st, const pg8::Unit& u, int wr, int wc, int fr, int fq) const {
        bf16* yp = y + (size_t)(u.pm * 256 + wr * 64 + fr) * 1024 + u.pn * 128 + wc * 32 + fq * 8;
#pragma unroll
        for (int ai = 0; ai < 2; ++ai)
#pragma unroll
            for (int m = 0; m < 4; ++m) { const f32x4 a = st.Y[ai][m][0], b = st.Y[ai][m][1]; u32x4 w; w.x = pk2(a[0], a[1]); w.y = pk2(a[2], a[3]); w.z = pk2(b[0], b[1]); w.w = pk2(b[2], b[3]);
                *(u32x4*)(yp + (size_t)(ai * 128 + m * 16) * 1024) = w; }
    }
};
template <bool FIRST> struct EpiMerge {
    static constexpr bool PERM = true, AFTER_DRAIN = false;
    bf16* y; const unsigned char* gate; int goff;
    __device__ __forceinline__ void operator()(const f32x4 (&acc)[2][2][4][2], const pg8::Unit& u, int wr, int wc, int fr, int fq) const {
        const int row0 = u.pm * 256 + wr * 64 + fr; const int col0 = u.pn * 256 + wc * 32 + fq * 8; const float s = 1.0f / 255.0f;
#pragma unroll
        for (int ai = 0; ai < 2; ++ai) {
            u32x2 gq[4][2]; u32x4 old[4][2];
#pragma unroll
            for (int m = 0; m < 4; ++m)
#pragma unroll
                for (int bj = 0; bj < 2; ++bj) { const size_t row = (size_t)(row0 + ai * 128 + m * 16); gq[m][bj] = *(const u32x2*)(gate + row * 3072 + goff + col0 + bj * 128);
                    if (!FIRST) old[m][bj] = *(const u32x4*)(y + row * 1024 + col0 + bj * 128); }
#pragma unroll
            for (int m = 0; m < 4; ++m)
#pragma unroll
                for (int bj = 0; bj < 2; ++bj) { const f32x4 v0 = acc[ai][bj][m][0], v1 = acc[ai][bj][m][1]; const u32x2 g = gq[m][bj];
                    float o[8];
                    o[0] = v0[0] * ((float)(g.x & 255u) * s); o[1] = v0[1] * ((float)((g.x >> 8) & 255u) * s); o[2] = v0[2] * ((float)((g.x >> 16) & 255u) * s); o[3] = v0[3] * ((float)(g.x >> 24) * s);
                    o[4] = v1[0] * ((float)(g.y & 255u) * s); o[5] = v1[1] * ((float)((g.y >> 8) & 255u) * s); o[6] = v1[2] * ((float)((g.y >> 16) & 255u) * s); o[7] = v1[3] * ((float)(g.y >> 24) * s);
                    if (!FIRST) { const u32x4 od = old[m][bj]; o[0] += bflo(od.x); o[1] += bfhi(od.x); o[2] += bflo(od.y); o[3] += bfhi(od.y); o[4] += bflo(od.z); o[5] += bfhi(od.z); o[6] += bflo(od.w); o[7] += bfhi(od.w); }
                    u32x4 w; w.x = pk2(o[0], o[1]); w.y = pk2(o[2], o[3]); w.z = pk2(o[4], o[5]); w.w = pk2(o[6], o[7]);
                    *(u32x4*)(y + (size_t)(row0 + ai * 128 + m * 16) * 1024 + col0 + bj * 128) = w; }
            asm volatile("" ::: "memory");
        }
    }
};
template <bool EMIT, bool NH = false> struct EpiResid {
    static constexpr int NBJ = NH ? 1 : 2;
    static constexpr bool PERM = true, AFTER_DRAIN = false;
    const float* xin_lat; const float* xin_ctx; float* xout_lat; float* xout_ctx; const float* gvec  ; int rowbase;
    bf16* hn; const float* gam  ; float* ssq;
    __device__ __forceinline__ void operator()(const f32x4 (&acc)[2][2][4][2], const pg8::Unit& u, int wr, int wc, int fr, int fq) const {
        const int grow0 = rowbase + u.pm * 256; const bool isc = grow0 >= MLAT; const int j = isc ? 8 : (grow0 >> 13);
        const float* xi = isc ? xin_ctx - (size_t)MLAT * DM : xin_lat; float* xo = isc ? xout_ctx - (size_t)MLAT * DM : xout_lat;
        const int row0 = grow0 + wr * 64 + fr; const int colb = u.pn * (NH ? 128 : 256) + wc * 32 + fq * 8;
        f32x4 gg[2][2], gm_[2][2];
#pragma unroll
        for (int bj = 0; bj < NBJ; ++bj) { const float* gp = gvec + (size_t)j * 6144 + colb + bj * 128; gg[bj][0] = *(const f32x4*)gp; gg[bj][1] = *(const f32x4*)(gp + 4);
            if (EMIT) { const float* mp = gam + (size_t)j * 1024 + colb + bj * 128; gm_[bj][0] = *(const f32x4*)mp; gm_[bj][1] = *(const f32x4*)(mp + 4); } }
#pragma unroll
        for (int ai = 0; ai < 2; ++ai)
#pragma unroll
            for (int mp2 = 0; mp2 < 2; ++mp2) {
                f32x4 xv[2][2][2];
#pragma unroll
                for (int mm = 0; mm < 2; ++mm)
#pragma unroll
                    for (int bj = 0; bj < NBJ; ++bj) { const float* p = xi + (size_t)(row0 + ai * 128 + (2 * mp2 + mm) * 16) * DM + colb + bj * 128; xv[mm][bj][0] = *(const f32x4*)p; xv[mm][bj][1] = *(const f32x4*)(p + 4); }
#pragma unroll
                for (int mm = 0; mm < 2; ++mm) { const int m = 2 * mp2 + mm; const size_t row = (size_t)(row0 + ai * 128 + m * 16); float sq = 0.f;
#pragma unroll
                    for (int bj = 0; bj < NBJ; ++bj) { const f32x4 x0 = xv[mm][bj][0] + gg[bj][0] * acc[ai][bj][m][0], x1 = xv[mm][bj][1] + gg[bj][1] * acc[ai][bj][m][1];
                        float* op = xo + row * DM + colb + bj * 128; *(f32x4*)op = x0; *(f32x4*)(op + 4) = x1;
                        if (EMIT) { sq += ((x0[0] * x0[0] + x0[1] * x0[1]) + (x0[2] * x0[2] + x0[3] * x0[3])) + ((x1[0] * x1[0] + x1[1] * x1[1]) + (x1[2] * x1[2] + x1[3] * x1[3]));
                            const f32x4 h0 = x0 * gm_[bj][0], h1 = x1 * gm_[bj][1]; u32x4 w; w.x = pk2(h0[0], h0[1]); w.y = pk2(h0[2], h0[3]); w.z = pk2(h1[0], h1[1]); w.w = pk2(h1[2], h1[3]);
                            *(u32x4*)(hn + row * DM + colb + bj * 128) = w; } }
                    if (EMIT) { sq += __shfl_xor(sq, 16); sq += __shfl_xor(sq, 32); if (fq == 0) atomicAdd(ssq + row, sq); } }
                asm volatile("" ::: "memory");
            }
    }
};
__device__ __forceinline__ float dpp_prev(float self, float up) {
    const int seam = __builtin_amdgcn_mov_dpp(__builtin_bit_cast(int, up), 0x121  , 0xf, 0xf, false);
    return __builtin_bit_cast(float, __builtin_amdgcn_update_dpp(seam, __builtin_bit_cast(int, self), 0x111  , 0xf, 0xf, false)); }
__device__ __forceinline__ float dpp_next(float self, float dn) {
    const int seam = __builtin_amdgcn_mov_dpp(__builtin_bit_cast(int, dn), 0x12F  , 0xf, 0xf, false);
    return __builtin_bit_cast(float, __builtin_amdgcn_update_dpp(seam, __builtin_bit_cast(int, self), 0x101  , 0xf, 0xf, false)); }
struct EpiUpConv {
    static constexpr bool PERM = true, AFTER_DRAIN = false;
    bf16* act; float* raw; const LAS float* slot  ; const float* cw  ; const float* cb  ; LAS float* X  ;
    __device__ __forceinline__ void operator()(f32x4 (&acc)[2][2][4][2], const pg8::Unit& u, int wr, int wc, int fr_, int fq_) const {
        int fr = fr_, fq = fq_; asm volatile("" : "+v"(fr), "+v"(fq));
        const int grow0 = u.pm * 256; const int row0 = grow0 + wr * 64 + fr; const int cl = wc * 32 + fq * 8;
        { f32x4 sw[2][2]; float rsv[2][4]; const LAS float* sl = slot + (u.seq & 1) * 512;
#pragma unroll
          for (int bj = 0; bj < 2; ++bj) { const LAS float* sp = sl + 256 + bj * 128 + cl; sw[bj][0] = *(const LAS f32x4*)sp; sw[bj][1] = *(const LAS f32x4*)(sp + 4); }
#pragma unroll
          for (int ai = 0; ai < 2; ++ai)
#pragma unroll
              for (int m = 0; m < 4; ++m) rsv[ai][m] = sl[wr * 64 + fr + ai * 128 + m * 16];
#pragma unroll
          for (int ai = 0; ai < 2; ++ai)
#pragma unroll
              for (int m = 0; m < 4; ++m) { const float rs = rsqrtf(rsv[ai][m] * (1.0f / DM) + NORM_EPS);
#pragma unroll
                  for (int bj = 0; bj < 2; ++bj)
#pragma unroll
                      for (int n = 0; n < 2; ++n) { acc[ai][bj][m][n] = acc[ai][bj][m][n] * rs + sw[bj][n]; asm volatile("" : "+v"(acc[ai][bj][m][n])); } } }
#pragma unroll
        for (int ai = 0; ai < 2; ++ai) { const int bidx = 2 * ai + wr;
            if (fr == 0) {
#pragma unroll
                for (int bj = 0; bj < 2; ++bj) { LAS float* xp = X + (2 * bidx) * 256 + bj * 128 + cl; *(LAS f32x4*)xp = acc[ai][bj][0][0]; *(LAS f32x4*)(xp + 4) = acc[ai][bj][0][1]; } }
            if (fr == 15) {
#pragma unroll
                for (int bj = 0; bj < 2; ++bj) { LAS float* xp = X + (2 * bidx + 1) * 256 + bj * 128 + cl; *(LAS f32x4*)xp = acc[ai][bj][3][0]; *(LAS f32x4*)(xp + 4) = acc[ai][bj][3][1]; } }
        }
        if (wr == 0 && fr < 2) {
#pragma unroll
            for (int bj = 0; bj < 2; ++bj) { float* rp = raw + ((size_t)u.pm * 4 + fr) * NUP + u.pn * 256 + bj * 128 + cl; *(f32x4*)rp = acc[0][bj][0][0]; *(f32x4*)(rp + 4) = acc[0][bj][0][1]; } }
        if (wr == 1 && fr >= 14) {
#pragma unroll
            for (int bj = 0; bj < 2; ++bj) { float* rp = raw + ((size_t)u.pm * 4 + fr - 12) * NUP + u.pn * 256 + bj * 128 + cl; *(f32x4*)rp = acc[1][bj][3][0]; *(f32x4*)(rp + 4) = acc[1][bj][3][1]; } }
        asm volatile("s_waitcnt lgkmcnt(0)" ::: "memory"); __builtin_amdgcn_s_barrier(); asm volatile("" ::: "memory"); __builtin_amdgcn_sched_barrier(0);
        const int ch = u.pn * 128 + cl;
#pragma unroll
        for (int ai = 0; ai < 2; ++ai) { const int bidx = 2 * ai + wr;
            u32x2 wlo[4];
#pragma unroll
            for (int n = 0; n < 2; ++n) {
                f32x4 ca[4];
#pragma unroll
                for (int bj = 0; bj < 2; ++bj) {
                    const float* wp = cw + bj * DFF + ch + 4 * n;
                    const f32x4 w0 = *(const f32x4*)wp, w1 = *(const f32x4*)(wp + NUP), w2 = *(const f32x4*)(wp + 2 * NUP), bb = *(const f32x4*)(cb + bj * DFF + ch + 4 * n);
                    const f32x4 xp = bidx > 0 ? *(const LAS f32x4*)(X + (2 * bidx - 1) * 256 + bj * 128 + cl + 4 * n) : (f32x4){0.f, 0.f, 0.f, 0.f};
                    const f32x4 xn = bidx < 3 ? *(const LAS f32x4*)(X + (2 * bidx + 2) * 256 + bj * 128 + cl + 4 * n) : (f32x4){0.f, 0.f, 0.f, 0.f};
#pragma unroll
                    for (int m = 0; m < 4; ++m) { const f32x4 self = acc[ai][bj][m][n]; const f32x4 us = m == 0 ? xp : acc[ai][bj][m == 0 ? 0 : m - 1][n]; const f32x4 ds = m == 3 ? xn : acc[ai][bj][m == 3 ? 3 : m + 1][n]; f32x4 o;
#pragma unroll
                        for (int e = 0; e < 4; ++e) { const float pv = dpp_prev(self[e], us[e]); const float nx = dpp_next(self[e], ds[e]); o[e] = bb[e] + w0[e] * pv + w1[e] * self[e] + w2[e] * nx; }
                        asm volatile("" : "+v"(o));
                        if (bj == 0) ca[m] = o;
                        else { const bool skip = (bidx == 0 && m == 0 && fr == 0) || (bidx == 3 && m == 3 && fr == 15);
                            u32x2 w; w.x = pk2(ca[m][0] * sigmoidf_(ca[m][0]) * o[0], ca[m][1] * sigmoidf_(ca[m][1]) * o[1]); w.y = pk2(ca[m][2] * sigmoidf_(ca[m][2]) * o[2], ca[m][3] * sigmoidf_(ca[m][3]) * o[3]);
                            if (n == 0) wlo[m] = w;
                            else if (!skip) { u32x4 w4; w4.x = wlo[m].x; w4.y = wlo[m].y; w4.z = w.x; w4.w = w.y; *(u32x4*)(act + (size_t)(row0 + ai * 128 + m * 16) * DFF + ch) = w4; } }
                        __builtin_amdgcn_sched_barrier(0); }
                    asm volatile("" ::: "memory");
                }
            }
        }
    }
};
struct EpiPlain {
    static constexpr bool PERM = true, AFTER_DRAIN = false;
    bf16* O; int ldc;
    __device__ __forceinline__ void operator()(const f32x4 (&acc)[2][2][4][2], const pg8::Unit& u, int wr, int wc, int fr, int fq) const {
        const int row0 = u.pm * 256 + wr * 64 + fr;
#pragma unroll
        for (int ai = 0; ai < 2; ++ai)
#pragma unroll
            for (int m = 0; m < 4; ++m) { bf16* rp = O + (size_t)(row0 + ai * 128 + m * 16) * ldc + u.pn * 256 + wc * 32 + fq * 8;
#pragma unroll
                for (int bj = 0; bj < 2; ++bj) { const f32x4 v0 = acc[ai][bj][m][0], v1 = acc[ai][bj][m][1]; u32x4 w; w.x = pk2(v0[0], v0[1]); w.y = pk2(v0[2], v0[3]); w.z = pk2(v1[0], v1[1]); w.w = pk2(v1[2], v1[3]); *(u32x4*)(rp + bj * 128) = w; } }
    }
};

struct Args { const float* in[32]; float* out; unsigned char* ws; int ph_lo, ph_hi; };

typedef const __attribute__((address_space(4))) Args* KArgP;
__device__ __forceinline__ KArgP kargs() { KArgP p = (KArgP)__builtin_amdgcn_kernarg_segment_ptr(); asm volatile("" : "+s"(p)); return p; }
constexpr int GRID = 256;
struct Ctx {
    LAS unsigned char* lds; int tid, lane, wave, G, bid;
    KArgP ap;
};
__device__ __forceinline__ bool phase_enter(Ctx& C) { C.ap = kargs(); asm volatile("" : "+v"(C.tid), "+v"(C.lane)); return true; }
#define WSP(T, off) ((T*)(C.ap->ws + (off)))
#define INP(i) (C.ap->in[i])
#define OUTP (C.ap->out)

__device__ __forceinline__ void sincos_d(double th, double& s, double& c) {
    const double TWO_PI = 6.283185307179586476925287;
    const double n = rint(th / TWO_PI); const double r = (th - n * 6.28318530717958623200) - n * 2.4492935982947064e-16;
    const double x = r * 0.25, x2 = x * x;
    double ss = x * (1.0 - x2 / 6.0 * (1.0 - x2 / 20.0 * (1.0 - x2 / 42.0 * (1.0 - x2 / 72.0 * (1.0 - x2 / 110.0 * (1.0 - x2 / 156.0 * (1.0 - x2 / 210.0)))))));
    double cc = 1.0 - x2 / 2.0 * (1.0 - x2 / 12.0 * (1.0 - x2 / 30.0 * (1.0 - x2 / 56.0 * (1.0 - x2 / 90.0 * (1.0 - x2 / 132.0 * (1.0 - x2 / 182.0 * (1.0 - x2 / 240.0)))))));
    double s2 = 2.0 * ss * cc, c2 = 1.0 - 2.0 * ss * ss;
    s = 2.0 * s2 * c2; c = 1.0 - 2.0 * s2 * s2;
}

template <int MODE> __device__ __forceinline__ void cvt_T(const Ctx& C, const float* src, int K, int Nsrc, bf16* dst, int Ndst, int ldd = 0, int koff = 0) {
    if (ldd == 0) ldd = K;
    LAS float* scr = (LAS float*)(C.lds + C.wave * 8448);
    const int nblk = Ndst / 32, nitems = (K / 64) * nblk; const int lane = C.lane;
    for (int it = C.bid * 8 + C.wave; it < nitems; it += C.G * 8) {
        const int kb = it / nblk, nb = it % nblk, k0 = 64 * kb, n0 = 32 * nb; const int n = n0 + (lane & 31);
        int sn = n; if (MODE == 1) sn = (n < 2064) ? n : (n < 2304 ? -1 : n - 240);
        if (MODE == 2) sn = ((n >> 7) & 1) * DFF + (n >> 8) * 128 + (n & 127);
        float v[32];
#pragma unroll
        for (int i = 0; i < 32; ++i) v[i] = sn >= 0 ? src[(size_t)(k0 + 2 * i + (lane >> 5)) * Nsrc + sn] : 0.f;
#pragma unroll
        for (int i = 0; i < 32; ++i) scr[(2 * i + (lane >> 5)) * 33 + (lane & 31)] = v[i];
        asm volatile("s_waitcnt lgkmcnt(0)" ::: "memory");
        const int c = lane & 7;
#pragma unroll
        for (int j = 0; j < 4; ++j) { const int nn = (lane >> 3) + 8 * j; const LAS float* sp = scr + (8 * c) * 33 + nn;
            u32x4 o; o.x = pk2(sp[0 * 33], sp[1 * 33]); o.y = pk2(sp[2 * 33], sp[3 * 33]); o.z = pk2(sp[4 * 33], sp[5 * 33]); o.w = pk2(sp[6 * 33], sp[7 * 33]);
            *(u32x4*)(dst + (size_t)(n0 + nn) * ldd + koff + k0 + 8 * c) = o; }
        asm volatile("s_waitcnt lgkmcnt(0)" ::: "memory");
    }
}

__device__ __forceinline__ void pro0(const Ctx& C) {
    for (int l = 0; l < 2; ++l) {
        cvt_T<1>(C, INP(8) + (size_t)l * 1024 * 5136, 1024, 5136, WSP(bf16, WS_WIN) + (size_t)l * NIN * 1024, NIN);
        cvt_T<0>(C, INP(23) + (size_t)l * 512 * 1024, 512, 1024, WSP(bf16, WS_WBA) + (size_t)l * 1024 * 1024, 1024, 1024, 0);
        cvt_T<0>(C, INP(24) + (size_t)l * 256 * 1024, 256, 1024, WSP(bf16, WS_WBA) + (size_t)l * 1024 * 1024, 1024, 1024, 512);
        cvt_T<0>(C, INP(25) + (size_t)l * 256 * 1024, 256, 1024, WSP(bf16, WS_WBA) + (size_t)l * 1024 * 1024, 1024, 1024, 768);
        cvt_T<0>(C, INP(26) + (size_t)l * 1024 * 1024, 1024, 1024, WSP(bf16, WS_WOUT) + (size_t)l * 1024 * 1024, 1024);
        cvt_T<2>(C, INP(27) + (size_t)l * 1024 * NUP, 1024, NUP, WSP(bf16, WS_WUP) + (size_t)l * NUP * 1024, NUP);
        cvt_T<0>(C, INP(30) + (size_t)l * DFF * 1024, DFF, 1024, WSP(bf16, WS_WDN) + (size_t)l * 1024 * DFF, 1024);
        cvt_T<0>(C, INP(18) + (size_t)l * 256 * 256, 256, 256, WSP(bf16, WS_WGLU) + (size_t)l * 256 * 256, 256);
    }
    __syncthreads();
    {
        LAS float* sl = (LAS float*)C.lds;
        float* modp = WSP(float, WS_MODP);
        for (int it = C.bid; it < 384; it += C.G) {
            const int l = it / 192, r = it % 192, ks = r / 12, nb = r % 12, n = nb * 512 + C.tid;
            __syncthreads();
            for (int e = C.tid; e < 576; e += 512) { const int j = e >> 6, k = ks * 64 + (e & 63); const float cv = (j < 8) ? INP(1)[j * 1024 + k] : INP(3)[k]; sl[e] = cv / (1.0f + expf(-cv)); }
            __syncthreads();
            float a[9];
#pragma unroll
            for (int j = 0; j < 9; ++j) a[j] = 0.f;
            const float* w = INP(4) + ((size_t)l * 1024 + ks * 64) * 6144 + n;
#pragma unroll 16
            for (int k = 0; k < 64; ++k) { const float wv = w[(size_t)k * 6144];
#pragma unroll
                for (int j = 0; j < 9; ++j) a[j] += sl[j * 64 + k] * wv; }
#pragma unroll
            for (int j = 0; j < 9; ++j) modp[((size_t)(l * 16 + ks) * 9 + j) * 6144 + n] = a[j];
        }
        __syncthreads();
    }
    { float* q = WSP(float, WS_SSQ) + MTOT; for (long i = (long)C.bid * 512 + C.tid; i < (long)3 * MTOT; i += (long)C.G * 512) q[i] = 0.f; }
    const int gt = (GRID - 1 - C.bid) * 512 + C.tid;
    if (gt < 4096) {
        const int p = gt & 63, g = (gt >> 6) & 15, d = (gt >> 10) & 1, l = gt >> 11;
        const size_t pi = (((size_t)l * 2 + d) * 16 + g) * 64 + p;
        const double are = (double)INP(10)[pi], aim = (double)INP(11)[pi];
        const double dt = exp((double)INP(12)[(l * 2 + d) * 16 + g]);
        const double dre = dt * are, dim = dt * aim;
        float* lp = WSP(float, WS_LP) + pi * 66;
        double l1r = 0, l1i = 0;
        for (int k = 0; k <= 32; ++k) { double s, c; sincos_d((double)k * dim, s, c); const double mg = exp((double)k * dre); lp[2 * k] = (float)(mg * c); lp[2 * k + 1] = (float)(mg * s); if (k == 1) { l1r = mg * c; l1i = mg * s; } }
        const double den = are * are + aim * aim;
        const double cr = ((l1r - 1.0) * are + l1i * aim) / den, ci = (l1i * are - (l1r - 1.0) * aim) / den;
        float* bb = WSP(float, WS_BB) + pi * 32;
        const size_t bi = (((size_t)l * 16 + g) * 64 + p) * 16;
        for (int c = 0; c < 16; ++c) { const double br = (double)INP(13)[bi + c], bim = (double)INP(14)[bi + c]; bb[2 * c] = (float)(cr * br - ci * bim); bb[2 * c + 1] = (float)(cr * bim + ci * br); }
    }
    if (gt >= 4096 && gt < 4096 + 2048) {
        const int e = gt - 4096, pos = e >> 4, i = e & 15;
        const double inv = exp(-(double)i / 16.0 * 9.210340371976184);
        double s, c; sincos_d((double)pos * inv, s, c);
        float* rt = WSP(float, WS_ROPE) + e * 2; rt[0] = (float)c; rt[1] = (float)s;
    }
}
__device__ __forceinline__ void pro1(const Ctx& C) {
    const long gt = (long)C.bid * 512 + C.tid, NT = (long)C.G * 512;
    { const float* modp = WSP(float, WS_MODP); float* modv = WSP(float, WS_MODV);
      for (long i = gt; i < 2 * 9 * 6144; i += NT) { const int n = (int)(i % 6144), j = (int)((i / 6144) % 9), l = (int)(i / (9 * 6144)); float s = INP(5)[l * 6144 + n];
          for (int ks = 0; ks < 16; ++ks) s += modp[((size_t)(l * 16 + ks) * 9 + j) * 6144 + n];
          modv[i] = s; } }
    { const float* LP = WSP(float, WS_LP); const float* BB = WSP(float, WS_BB); float* KD = WSP(float, WS_KD);
      for (long i = gt; i < 2L * 16 * 2 * 32 * 16; i += NT) {
          const int cp = (int)(i & 15), k = (int)((i >> 4) & 31); const int lgd = __builtin_amdgcn_readfirstlane((int)(i >> 9)); const int d = lgd & 1, lg = lgd >> 1;
          const float* cre = INP(15) + (size_t)lg * 16 * 64; const float* cim = INP(16) + (size_t)lg * 16 * 64;
          const size_t pb = ((size_t)(lg >> 4) * 2 + d) * 16 * 64 + (size_t)(lg & 15) * 64;
          float acc[16];
#pragma unroll
          for (int c = 0; c < 16; ++c) acc[c] = 0.f;
          for (int p0 = 0; p0 < 64; p0 += 4) {
#pragma unroll
              for (int pp = 0; pp < 4; ++pp) { const int p = p0 + pp;
                  const float lr = LP[(pb + p) * 66 + 2 * k], li = LP[(pb + p) * 66 + 2 * k + 1]; const float br = BB[(pb + p) * 32 + 2 * cp], bi = BB[(pb + p) * 32 + 2 * cp + 1];
                  const float zr = lr * br - li * bi, zi = lr * bi + li * br;
#pragma unroll
                  for (int c = 0; c < 16; ++c) acc[c] += cre[c * 64 + p] * zr - cim[c * 64 + p] * zi; } }
#pragma unroll
          for (int c = 0; c < 16; ++c) KD[((size_t)lgd * 32 + k) * 256 + c * 16 + cp] = acc[c]; } }
    { const float* LP = WSP(float, WS_LP); const float* BB = WSP(float, WS_BB);
      bf16* W1 = WSP(bf16, WS_W1);
      for (long i = gt; i < 2L * 16 * 256 * 64; i += NT) {
          const int kc = (int)(i & 63), n = (int)((i >> 6) & 255), g = (int)((i >> 14) & 15), l = (int)(i >> 18);
          const int tau = kc >> 1, c0 = (kc & 1) * 8, p = n & 63, part = (n >> 6) & 1, d = n >> 7;
          const size_t pi = (((size_t)l * 2 + d) * 16 + g) * 64 + p; const int e = d == 0 ? 31 - tau : tau;
          const float lr = LP[pi * 66 + 2 * e], li = LP[pi * 66 + 2 * e + 1]; float v[8];
#pragma unroll
          for (int j = 0; j < 8; ++j) { const float br = BB[pi * 32 + 2 * (c0 + j)], bi = BB[pi * 32 + 2 * (c0 + j) + 1]; v[j] = part == 0 ? (lr * br - li * bi) : (lr * bi + li * br); }
          u32x4 w; w.x = pk2(v[0], v[1]); w.y = pk2(v[2], v[3]); w.z = pk2(v[4], v[5]); w.w = pk2(v[6], v[7]);
          *(u32x4*)(W1 + (((size_t)l * 16 + g) * 256 + n) * 512 + kc * 8) = w; } }
}
__device__ __forceinline__ void pro2(const Ctx& C) {
    const long gt = (long)C.bid * 512 + C.tid, NT = (long)C.G * 512;
    { const float* modv = WSP(float, WS_MODV); float* gam = WSP(float, WS_GAM);
      for (long i = gt; i < 2 * 2 * 9 * 1024; i += NT) { const int k = (int)(i & 1023), j = (int)((i >> 10) % 9), w = (int)((i / 9216) & 1), l = (int)(i / 18432);
          gam[i] = (w == 0 ? INP(6) : INP(7))[l * 1024 + k] * (1.0f + modv[((size_t)l * 9 + j) * 6144 + (w == 0 ? 1024 : 4096) + k]); } }
    { const float* modv = WSP(float, WS_MODV); LAS float* red = (LAS float*)C.lds;
      const int nbi = NIN / 128, nbu = NUP / 128, per = nbi + nbu;
      for (int it = C.bid; it < 2 * per; it += C.G) {
          const int l = it / per, r = it % per; const bool isu = r >= nbi; const int n = (isu ? r - nbi : r) * 128 + 2 * C.lane;
          int sn = n; if (!isu) sn = (n < 2064) ? n : (n < 2304 ? -1 : n - 240); else sn = ((n >> 7) & 1) * DFF + (n >> 8) * 128 + (n & 127);
          const float* W = isu ? INP(27) + (size_t)l * 1024 * NUP : INP(8) + (size_t)l * 1024 * 5136; const int ldw = isu ? NUP : 5136;
          const float* sh = modv + (size_t)l * 9 * 6144 + (isu ? 3072 : 0);
          float a0[9], a1[9];
#pragma unroll
          for (int j = 0; j < 9; ++j) { a0[j] = 0.f; a1[j] = 0.f; }
          const int kb = C.wave * 128;
#pragma unroll 8
          for (int k = kb; k < kb + 128; ++k) { f32x2_t wv = {0.f, 0.f}; if (sn >= 0) wv = *(const f32x2_t*)(W + (size_t)k * ldw + sn);
#pragma unroll
              for (int j = 0; j < 9; ++j) { const float sv = sh[(size_t)j * 6144 + k]; a0[j] += sv * wv.x; a1[j] += sv * wv.y; } }
          __syncthreads();
#pragma unroll
          for (int j = 0; j < 9; ++j) { f32x2_t o = {a0[j], a1[j]}; *(LAS f32x2_t*)(red + (C.wave * 9 + j) * 128 + 2 * C.lane) = o; }
          __syncthreads();
          for (int e = C.tid; e < 1152; e += 512) { float t = 0.f;
#pragma unroll
              for (int w = 0; w < 8; ++w) t += red[w * 1152 + e];
              const int j = e >> 7, nn = (isu ? r - nbi : r) * 128 + (e & 127);
              if (isu) WSP(float, WS_SHWU)[((size_t)l * 9 + j) * NUP + nn] = t; else WSP(float, WS_SHWI)[((size_t)l * 9 + j) * NIN + nn] = t; }
      }
      __syncthreads(); }
    const float* LP = WSP(float, WS_LP); const float* BB = WSP(float, WS_BB); const float* KD = WSP(float, WS_KD);
    { bf16* W2 = WSP(bf16, WS_W2);
      for (long i = gt; i < 2L * 16 * 512 * 96; i += NT) {
          const int kc = (int)(i % 96); const long r = i / 96; const int n = (int)(r & 511), g = (int)((r >> 9) & 15), l = (int)(r >> 13);
          const int t = n >> 4, c = n & 15; float v[8];
          if (kc < 64) { const int tau = kc >> 1, c0 = (kc & 1) * 8;
              const float* kf = KD + ((((size_t)l * 16 + g) * 2 + 0) * 32) * 256; const float* kb = KD + ((((size_t)l * 16 + g) * 2 + 1) * 32) * 256;
#pragma unroll
              for (int j = 0; j < 8; ++j) { const int cp = c0 + j; float s = 0.f;
                  if (tau <= t) s += kf[(t - tau) * 256 + c * 16 + cp];
                  if (tau >= t) s += kb[(tau - t) * 256 + c * 16 + cp];
                  if (tau == t && cp == c) s += INP(17)[l * 256 + g * 16 + c];
                  v[j] = s; }
          } else { const int kk = (kc - 64) * 8; const int d = kk >> 7, part = (kk >> 6) & 1, p0 = kk & 63; const int e = d == 0 ? t + 1 : 32 - t;
              const float* cre = INP(15) + (((size_t)l * 16 + g) * 16 + c) * 64; const float* cim = INP(16) + (((size_t)l * 16 + g) * 16 + c) * 64;
#pragma unroll
              for (int j = 0; j < 8; ++j) { const int p = p0 + j; const size_t pi = (((size_t)l * 2 + d) * 16 + g) * 64 + p; const float lr = LP[pi * 66 + 2 * e], li = LP[pi * 66 + 2 * e + 1];
                  const float zr = cre[p] * lr - cim[p] * li, zi = cre[p] * li + cim[p] * lr; v[j] = part == 0 ? zr : -zi; } }
          u32x4 w; w.x = pk2(v[0], v[1]); w.y = pk2(v[2], v[3]); w.z = pk2(v[4], v[5]); w.w = pk2(v[6], v[7]);
          *(u32x4*)(W2 + (((size_t)l * 16 + g) * 512 + n) * 768 + kc * 8) = w; } }
}

__device__ __forceinline__ void norm_emit_phase(const Ctx& C, const float* xlat, const float* xctx, const float* gain, const float* modl  , bf16* hn, float* ssq, int nrows) {
    const int gw = C.bid * 8 + C.wave, NGW = C.G * 8;
    auto rowp = [&](int r) -> const f32x4* { return (const f32x4*)(r < MLAT ? xlat + (size_t)r * DM : xctx + (size_t)(r - MLAT) * DM) + C.lane; };
    f32x4 v[4], nv[4];
    { const f32x4* x4 = rowp(gw < nrows ? gw : 0);
#pragma unroll
      for (int q = 0; q < 4; ++q) v[q] = x4[64 * q]; }
    for (int r = gw; r < nrows; r += NGW) {
        { const f32x4* n4 = rowp(r + NGW < nrows ? r + NGW : r);
#pragma unroll
          for (int q = 0; q < 4; ++q) nv[q] = n4[64 * q]; }
        const int j = r < MLAT ? (r >> 13) : 8; float s = 0.f;
#pragma unroll
        for (int q = 0; q < 4; ++q) s += (v[q].x * v[q].x + v[q].y * v[q].y) + (v[q].z * v[q].z + v[q].w * v[q].w);
        s = wave_sum(s);
        if (C.lane == 0) ssq[r] = s;
        const float* sv = modl + (size_t)j * 6144 + 1024;
        unsigned long long* o8 = (unsigned long long*)(hn + (size_t)r * DM) + C.lane;
#pragma unroll
        for (int q = 0; q < 4; ++q) { const f32x4 y = v[q] * (*(const f32x4*)(gain + 4 * C.lane + 256 * q) * (*(const f32x4*)(sv + 4 * C.lane + 256 * q) + 1.0f));
            o8[64 * q] = (unsigned long long)pk2(y.x, y.y) | ((unsigned long long)pk2(y.z, y.w) << 32); }
#pragma unroll
        for (int q = 0; q < 4; ++q) v[q] = nv[q];
    }
}
__device__ __forceinline__ void final_norm_phase(const Ctx& C, float* x, const float* gain) {
    const int gw = C.bid * 8 + C.wave, NGW = C.G * 8;
    f32x4 v[4], nv[4];
    { const f32x4* x4 = (const f32x4*)(x + (size_t)(gw < MLAT ? gw : 0) * DM) + C.lane;
#pragma unroll
      for (int q = 0; q < 4; ++q) v[q] = x4[64 * q]; }
    f32x4 gg[4];
#pragma unroll
    for (int q = 0; q < 4; ++q) gg[q] = *(const f32x4*)(gain + 4 * C.lane + 256 * q);
    for (int r = gw; r < MLAT; r += NGW) {
        { const f32x4* n4 = (const f32x4*)(x + (size_t)(r + NGW < MLAT ? r + NGW : r) * DM) + C.lane;
#pragma unroll
          for (int q = 0; q < 4; ++q) nv[q] = n4[64 * q]; }
        float s = 0.f;
#pragma unroll
        for (int q = 0; q < 4; ++q) s += (v[q].x * v[q].x + v[q].y * v[q].y) + (v[q].z * v[q].z + v[q].w * v[q].w);
        const float rs = 1.0f / sqrtf(wave_sum(s) * (1.0f / DM) + NORM_EPS);
        f32x4* x4 = (f32x4*)(x + (size_t)r * DM) + C.lane;
#pragma unroll
        for (int q = 0; q < 4; ++q) x4[64 * q] = v[q] * rs * gg[q];
#pragma unroll
        for (int q = 0; q < 4; ++q) v[q] = nv[q];
    }
}
__device__ __forceinline__ void rope_phase(const Ctx& C) {
    bf16* z1 = WSP(bf16, WS_Z1); const float* rt = WSP(float, WS_ROPE);
    constexpr long total = (long)MLAT * 40, NT = (long)GRID * 512; static_assert(total % (4 * NT) == 0, "four items per thread and trip");
    for (long i0 = (long)C.bid * 512 + C.tid; i0 < total; i0 += 4 * NT) {
        bf16* p[4]; const float* cs[4]; u32x4 a[4], b[4];
#pragma unroll
        for (int u = 0; u < 4; ++u) { const long i = i0 + u * NT;
            const int e = (int)(i % 40); const int row = (int)(i / 40); const int head = e >> 2, half = (e >> 1) & 1, ic = e & 1; const int t = row & 8191;
            p[u] = z1 + (size_t)row * ZP + (head < 8 ? head * 64 : 512 + (head - 8) * 64) + half * 32 + ic * 8;
            const int pos = half == 0 ? (t >> 6) : (t & 63); cs[u] = rt + (pos * 16 + ic * 8) * 2;
            a[u] = *(const u32x4*)p[u]; b[u] = *(const u32x4*)(p[u] + 16); }
#pragma unroll
        for (int u = 0; u < 4; ++u) {
            const unsigned aw[4] = {a[u].x, a[u].y, a[u].z, a[u].w}, bw[4] = {b[u].x, b[u].y, b[u].z, b[u].w}; unsigned oa[4], ob[4];
#pragma unroll
            for (int q = 0; q < 4; ++q) { const f32x4 c4 = *(const f32x4*)(cs[u] + 4 * q); const float c0 = c4.x, s0 = c4.y, c1 = c4.z, s1 = c4.w;
                const float u10 = bflo(aw[q]), u11 = bfhi(aw[q]), u20 = bflo(bw[q]), u21 = bfhi(bw[q]);
                oa[q] = pk2(u10 * c0 - u20 * s0, u11 * c1 - u21 * s1); ob[q] = pk2(u20 * c0 + u10 * s0, u21 * c1 + u11 * s1); }
            u32x4 wa, wb; wa.x = oa[0]; wa.y = oa[1]; wa.z = oa[2]; wa.w = oa[3]; wb.x = ob[0]; wb.y = ob[1]; wb.z = ob[2]; wb.w = ob[3];
            *(u32x4*)p[u] = wa; *(u32x4*)(p[u] + 16) = wb; }
    }
}
__device__ __forceinline__ void conv_phase(const Ctx& C, const bf16* u, bf16* act, const float* cw, const float* cb, int rbase, int nrows) {
    const long total = (long)(nrows / 32) * (DFF / 8);
    for (long i = (long)C.bid * 512 + C.tid; i < total; i += (long)C.G * 512) {
        const int jc = (int)(i % (DFF / 8)), blk = (int)(i / (DFF / 8)); const int rl0 = blk * 32, r0 = rbase + rl0, j0 = jc * 8;
        const int t0 = r0 < MLAT ? (r0 & 8191) : ((r0 - MLAT) & 255); const int len = r0 < MLAT ? 8192 : 256;
        float wa[3][8], wv[3][8], ba[8], bv[8];
#pragma unroll
        for (int h = 0; h < 2; ++h) {
#pragma unroll
            for (int k = 0; k < 3; ++k) { const f32x4 x = *(const f32x4*)(cw + k * NUP + j0 + 4 * h), y = *(const f32x4*)(cw + k * NUP + DFF + j0 + 4 * h);
#pragma unroll
                for (int e = 0; e < 4; ++e) { wa[k][4 * h + e] = x[e]; wv[k][4 * h + e] = y[e]; } }
            const f32x4 x = *(const f32x4*)(cb + j0 + 4 * h), y = *(const f32x4*)(cb + DFF + j0 + 4 * h);
#pragma unroll
            for (int e = 0; e < 4; ++e) { ba[4 * h + e] = x[e]; bv[4 * h + e] = y[e]; } }
        const bf16* ua = u + (size_t)rl0 * NUP + j0; bf16* ap = act + (size_t)rl0 * DFF + j0;
        const u32x4 z = {0u, 0u, 0u, 0u};
        u32x4 pa = t0 > 0 ? *(const u32x4*)(ua - NUP) : z, pv = t0 > 0 ? *(const u32x4*)(ua - NUP + DFF) : z;
        u32x4 ca = *(const u32x4*)ua, cv = *(const u32x4*)(ua + DFF);
        for (int k0 = 0; k0 < 32; k0 += 4) {
            u32x4 na[4], nv[4];
#pragma unroll
            for (int kk = 0; kk < 4; ++kk) { const int k = k0 + kk; const bool hn = (t0 + k) < len - 1;
                na[kk] = hn ? *(const u32x4*)(ua + (size_t)(k + 1) * NUP) : z; nv[kk] = hn ? *(const u32x4*)(ua + (size_t)(k + 1) * NUP + DFF) : z; }
#pragma unroll
            for (int kk = 0; kk < 4; ++kk) { const int k = k0 + kk;
                const unsigned P[4] = {pa.x, pa.y, pa.z, pa.w}, Cc[4] = {ca.x, ca.y, ca.z, ca.w}, N[4] = {na[kk].x, na[kk].y, na[kk].z, na[kk].w}, PV[4] = {pv.x, pv.y, pv.z, pv.w}, CV[4] = {cv.x, cv.y, cv.z, cv.w}, NV[4] = {nv[kk].x, nv[kk].y, nv[kk].z, nv[kk].w};
                unsigned o[4];
#pragma unroll
                for (int q = 0; q < 4; ++q) {
                    const float a0 = bflo(P[q]) * wa[0][2 * q] + bflo(Cc[q]) * wa[1][2 * q] + bflo(N[q]) * wa[2][2 * q] + ba[2 * q];
                    const float a1 = bfhi(P[q]) * wa[0][2 * q + 1] + bfhi(Cc[q]) * wa[1][2 * q + 1] + bfhi(N[q]) * wa[2][2 * q + 1] + ba[2 * q + 1];
                    const float v0 = bflo(PV[q]) * wv[0][2 * q] + bflo(CV[q]) * wv[1][2 * q] + bflo(NV[q]) * wv[2][2 * q] + bv[2 * q];
                    const float v1 = bfhi(PV[q]) * wv[0][2 * q + 1] + bfhi(CV[q]) * wv[1][2 * q + 1] + bfhi(NV[q]) * wv[2][2 * q + 1] + bv[2 * q + 1];
                    o[q] = pk2(a0 * sigmoidf_(a0) * v0, a1 * sigmoidf_(a1) * v1); }
                u32x4 w; w.x = o[0]; w.y = o[1]; w.z = o[2]; w.w = o[3];
                *(u32x4*)(ap + (size_t)k * DFF) = w;
                pa = ca; ca = na[kk]; pv = cv; cv = nv[kk]; }
        }
    }
}

__device__ __forceinline__ void seam_phase(const Ctx& C, const float* raw, bf16* act, const float* cw, const float* cb, int ntiles) {
    const long total = (long)ntiles * 2 * (DFF / 8);
    for (long i = (long)C.bid * 512 + C.tid; i < total; i += (long)C.G * 512) {
        const int jc = (int)(i % (DFF / 8)); const int rr = (int)(i / (DFF / 8)); const int pm = rr >> 1, last = rr & 1; const int ch = jc * 8, pn = ch >> 7, ci = ch & 127;
        const int r = pm * 256 + (last ? 255 : 0); const int t = r < MLAT ? (r & 8191) : ((r - MLAT) & 255); const int len = r < MLAT ? 8192 : 256;
        const float* base = raw + (size_t)pm * 4 * NUP + pn * 256 + ci;
        const float* pp = last ? base + 2 * NUP : (t > 0 ? base - 4 * NUP + 3 * NUP : nullptr);
        const float* cp = last ? base + 3 * NUP : base;
        const float* np = last ? (t < len - 1 ? base + 4 * NUP : nullptr) : base + NUP;
        float res[8];
#pragma unroll
        for (int h = 0; h < 2; ++h) {
            f32x4 A[3], V[3]; const f32x4 z = {0.f, 0.f, 0.f, 0.f};
            A[0] = pp ? *(const f32x4*)(pp + 4 * h) : z; V[0] = pp ? *(const f32x4*)(pp + 128 + 4 * h) : z;
            A[1] = *(const f32x4*)(cp + 4 * h); V[1] = *(const f32x4*)(cp + 128 + 4 * h);
            A[2] = np ? *(const f32x4*)(np + 4 * h) : z; V[2] = np ? *(const f32x4*)(np + 128 + 4 * h) : z;
            f32x4 a = *(const f32x4*)(cb + ch + 4 * h), v = *(const f32x4*)(cb + DFF + ch + 4 * h);
#pragma unroll
            for (int k = 0; k < 3; ++k) { a += A[k] * *(const f32x4*)(cw + k * NUP + ch + 4 * h); v += V[k] * *(const f32x4*)(cw + k * NUP + DFF + ch + 4 * h); }
#pragma unroll
            for (int e = 0; e < 4; ++e) res[4 * h + e] = a[e] * sigmoidf_(a[e]) * v[e];
        }
        u32x4 w; w.x = pk2(res[0], res[1]); w.y = pk2(res[2], res[3]); w.z = pk2(res[4], res[5]); w.w = pk2(res[6], res[7]);
        *(u32x4*)(act + (size_t)r * DFF + ch) = w;
    }
}

__device__ __forceinline__ f32x16 mfma32(bf16x8 a, bf16x8 b, f32x16 c) { return __builtin_amdgcn_mfma_f32_32x32x16_bf16(a, b, c, 0, 0, 0); }
__device__ __forceinline__ void attn_unit(const Ctx& C, bf16* z1, const float* sinkp, int b, int kvh, int q0, bool isctx) {
    constexpr int KB = 64 * 72 * 2, VB = 64 * 68 * 2, BUF = KB + VB + 64;
    const int w = C.wave, lane = C.lane, g = w >> 1, th = w & 1, c = lane & 31, hh = lane >> 5;
    const int qtok = q0 + th * 32 + c;
    const size_t qrow = isctx ? (size_t)MLAT + b * 256 + qtok : (size_t)b * 8192 + qtok;
    bf16* qptr = z1 + qrow * ZP + kvh * 256 + g * 64;
    int first = 0, nloc = 0;
    if (!isctx) { first = q0 >= 128 ? 0 : (q0 >= 64 ? 1 : 2); const int last = q0 + 128 < SEQ ? 4 : (q0 + 64 < SEQ ? 3 : 2); nloc = last - first + 1; }
    const int nt = nloc + 4;
    const bf16* kvbase = z1 + 512 + kvh * 64 + 8 * w;
    auto tile_row0 = [&](int t, int& kpos0) -> size_t { if (t < nloc) { kpos0 = q0 - 128 + 64 * (first + t); return (size_t)b * 8192 + kpos0; } kpos0 = 64 * (t - nloc); return (size_t)MLAT + b * 256 + kpos0; };
    int kp0; size_t r0 = tile_row0(0, kp0);
    u32x4 kv = *(const u32x4*)(kvbase + (r0 + lane) * ZP), vv = *(const u32x4*)(kvbase + (r0 + lane) * ZP + 128);
    bf16x8 qf[4];
#pragma unroll
    for (int s = 0; s < 4; ++s) qf[s] = *(const bf16x8*)(qptr + 16 * s + 8 * hh);
    const float L2E = 1.4426950408889634f;
    float m_run = sinkp[kvh * 4 + g] * L2E, l_run = hh == 0 ? 1.0f : 0.0f;
    f32x16 ot[2];
#pragma unroll
    for (int i = 0; i < 16; ++i) { ot[0][i] = 0.f; ot[1][i] = 0.f; }
    __syncthreads();
    for (int t = 0; t < nt; ++t) {
        LAS bf16* Ks = (LAS bf16*)(C.lds + (t & 1) * BUF); LAS bf16* VT = (LAS bf16*)(C.lds + (t & 1) * BUF + KB);
        { *(LAS u32x4*)(Ks + lane * 72 + 8 * w) = kv;
          const unsigned vw[4] = {vv.x, vv.y, vv.z, vv.w};
#pragma unroll
          for (int q = 0; q < 4; ++q) { VT[(8 * w + 2 * q) * 68 + lane] = (bf16)(vw[q] & 0xffffu); VT[(8 * w + 2 * q + 1) * 68 + lane] = (bf16)(vw[q] >> 16); } }
        const int kpos0 = kp0; const bool edge = t < nloc && (kpos0 == q0 - 128 || kpos0 == q0 + 128);
        if (t + 1 < nt) { r0 = tile_row0(t + 1, kp0); kv = *(const u32x4*)(kvbase + (r0 + lane) * ZP); vv = *(const u32x4*)(kvbase + (r0 + lane) * ZP + 128); }
        __syncthreads();
        f32x16 st[2];
#pragma unroll
        for (int kh = 0; kh < 2; ++kh) {
#pragma unroll
            for (int i = 0; i < 16; ++i) st[kh][i] = 0.f;
#pragma unroll
            for (int s = 0; s < 4; ++s) { const bf16x8 kf = *(const LAS bf16x8*)(Ks + (32 * kh + c) * 72 + 16 * s + 8 * hh); st[kh] = mfma32(kf, qf[s], st[kh]); }
        }
        if (edge) {
            asm volatile("");
#pragma unroll
            for (int kh = 0; kh < 2; ++kh)
#pragma unroll
                for (int i = 0; i < 16; ++i) { const int kp = kpos0 + 32 * kh + (i & 3) + 8 * (i >> 2) + 4 * hh; const int dd = qtok - kp; if (dd > 128 || dd < -128) st[kh][i] = -INFINITY; }
        }
        float mx = -INFINITY;
#pragma unroll
        for (int kh = 0; kh < 2; ++kh)
#pragma unroll
            for (int i = 0; i < 16; ++i) mx = fmaxf(mx, st[kh][i]);
        mx = fmaxf(mx, __shfl_xor(mx, 32));
        if (__builtin_amdgcn_ballot_w64(mx > m_run + 8.0f) != 0ull) {
            const float m_new = fmaxf(m_run, mx); const float alpha = __builtin_amdgcn_exp2f(m_run - m_new); m_run = m_new; l_run *= alpha;
#pragma unroll
            for (int i = 0; i < 16; ++i) { ot[0][i] *= alpha; ot[1][i] *= alpha; } }
        { const f32x16 d0 = st[0] - m_run, d1 = st[1] - m_run;
#pragma unroll
          for (int i = 0; i < 16; ++i) { st[0][i] = __builtin_amdgcn_exp2f(d0[i]); st[1][i] = __builtin_amdgcn_exp2f(d1[i]); } }
        const f32x16 s16 = st[0] + st[1]; const f32x8 s8 = s16.lo + s16.hi; const f32x4 s4 = s8.lo + s8.hi;
        l_run += (s4.x + s4.y) + (s4.z + s4.w);
#pragma unroll
        for (int kh = 0; kh < 2; ++kh)
#pragma unroll
            for (int s2 = 0; s2 < 2; ++s2) {
                u32x4 pw; pw.x = pk2(st[kh][8 * s2 + 0], st[kh][8 * s2 + 1]); pw.y = pk2(st[kh][8 * s2 + 2], st[kh][8 * s2 + 3]); pw.z = pk2(st[kh][8 * s2 + 4], st[kh][8 * s2 + 5]); pw.w = pk2(st[kh][8 * s2 + 6], st[kh][8 * s2 + 7]);
                const bf16x8 pf = __builtin_bit_cast(bf16x8, pw);
#pragma unroll
                for (int db = 0; db < 2; ++db) { const LAS bf16* vp = VT + (32 * db + c) * 68 + 32 * kh + 16 * s2 + 4 * hh;
                    const u32x2 lo = *(const LAS u32x2*)vp, hi = *(const LAS u32x2*)(vp + 8); u32x4 vw2; vw2.x = lo.x; vw2.y = lo.y; vw2.z = hi.x; vw2.w = hi.y;
                    ot[db] = mfma32(__builtin_bit_cast(bf16x8, vw2), pf, ot[db]); }
            }
    }
    const float lt = l_run + __shfl_xor(l_run, 32); const float inv = 1.0f / lt;
#pragma unroll
    for (int db = 0; db < 2; ++db)
#pragma unroll
        for (int i4 = 0; i4 < 4; ++i4) { u32x2 o; o.x = pk2(ot[db][4 * i4] * inv, ot[db][4 * i4 + 1] * inv); o.y = pk2(ot[db][4 * i4 + 2] * inv, ot[db][4 * i4 + 3] * inv);
            *(u32x2*)(qptr + 32 * db + 8 * i4 + 4 * hh) = o; }
}

__device__ __forceinline__ void ml_gate_tables(const Ctx& C, LAS float* tab, float g_i, float g_f) {
    if (C.wave < 2) { const int dir = C.wave, s = C.lane;
        const float lf = g_f; const float ig = g_i;
        float cs = lf;
#pragma unroll
        for (int o = 1; o < 64; o <<= 1) { const float nb = dir == 0 ? __shfl_up(cs, o) : __shfl_down(cs, o); const bool ok = dir == 0 ? (s >= o) : (s + o < 64); cs += ok ? nb : 0.f; }
        tab[dir * 192 + s] = cs; tab[dir * 192 + 64 + s] = ig - cs;
        const float tot = __shfl(cs, dir == 0 ? 63 : 0); if (s == 0) tab[dir * 192 + 128] = tot; }
}
struct MlaIn { u32x4 kv, vv; float gi0, gf0, gi1, gf1; };
__device__ __forceinline__ void mlA_load(const Ctx& C, int cidx, int h, MlaIn& R) {
    const bf16* z1 = WSP(bf16, WS_Z1); const float* gm = WSP(float, WS_GM); const int r0 = cidx * 64;
    const bf16* kp = z1 + (size_t)(r0 + C.lane) * ZP + 1024 + h * 64 + 8 * C.wave;
    R.kv = *(const u32x4*)kp; R.vv = *(const u32x4*)(kp + 256);
    const float* gr = gm + (size_t)(r0 + C.lane) * 16 + h; R.gi0 = gr[0]; R.gf0 = gr[4]; R.gi1 = gr[8]; R.gf1 = gr[12];
}
__device__ __forceinline__ void mlA_compute(const Ctx& C, int l, int cidx, int h, const MlaIn& R, int par) {
    LAS unsigned char* base = C.lds + par * 32768;
    LAS float* tab = (LAS float*)base;
    LAS bf16* KT = (LAS bf16*)(base + 2048);
    LAS bf16* VF = (LAS bf16*)(base + 2048 + 9216);
    LAS bf16* VB = (LAS bf16*)(base + 2048 + 2 * 9216);
    const int w = C.wave, lane = C.lane;
    const u32x4 kv = R.kv, vv = R.vv;
    float csf = R.gf0, csb = R.gf1;
#pragma unroll
    for (int o = 1; o < 64; o <<= 1) { const float nf = __shfl_up(csf, o), nb = __shfl_down(csb, o); csf += lane >= o ? nf : 0.f; csb += lane + o < 64 ? nb : 0.f; }
    const float totf = __shfl(csf, 63), totb = __shfl(csb, 0);
    { const float wf = __expf(totf + (R.gi0 - csf)), wb = __expf(totb + (R.gi1 - csb));
      const unsigned kw[4] = {kv.x, kv.y, kv.z, kv.w}, vw[4] = {vv.x, vv.y, vv.z, vv.w};
#pragma unroll
      for (int q = 0; q < 4; ++q) { const int d0 = 8 * w + 2 * q;
          KT[d0 * 72 + lane] = (bf16)(kw[q] & 0xffffu); KT[(d0 + 1) * 72 + lane] = (bf16)(kw[q] >> 16);
          const float v0 = bflo(vw[q]), v1 = bfhi(vw[q]);
          VF[d0 * 72 + lane] = f2bf(v0 * wf); VF[(d0 + 1) * 72 + lane] = f2bf(v1 * wf);
          VB[d0 * 72 + lane] = f2bf(v0 * wb); VB[(d0 + 1) * 72 + lane] = f2bf(v1 * wb); }
      if (w == 0) { tab[lane] = wf; tab[64 + lane] = wb; if (lane == 0) { tab[128] = totf; tab[129] = totb; } } }
    __syncthreads();
    const int dir = w >> 2, dblk = (w >> 1) & 1, eblk = w & 1, c = lane & 31, hh = lane >> 5;
    const LAS bf16* VX = dir == 0 ? VF : VB;
    f32x16 acc;
#pragma unroll
    for (int i = 0; i < 16; ++i) acc[i] = 0.f;
#pragma unroll
    for (int s = 0; s < 4; ++s) { const bf16x8 a = *(const LAS bf16x8*)(KT + (32 * dblk + c) * 72 + 16 * s + 8 * hh), bb = *(const LAS bf16x8*)(VX + (32 * eblk + c) * 72 + 16 * s + 8 * hh); acc = mfma32(a, bb, acc); }
    const size_t idx = ((size_t)cidx * 4 + h) * 2 + dir;
    bf16* dc = WSP(bf16, WS_DC) + idx * 4096 + (32 * eblk + c) * 64 + 32 * dblk + 4 * hh;
#pragma unroll
    for (int i4 = 0; i4 < 4; ++i4) { u32x2 o; o.x = pk2(acc[4 * i4], acc[4 * i4 + 1]); o.y = pk2(acc[4 * i4 + 2], acc[4 * i4 + 3]); *(u32x2*)(dc + 8 * i4) = o; }
    if (C.tid < 128) { const int dd = C.tid >> 6, d = C.tid & 63; float s = 0.f;
#pragma unroll
        for (int k8 = 0; k8 < 8; ++k8) { const u32x4 kk = *(const LAS u32x4*)(KT + d * 72 + 8 * k8); const LAS float* wp = tab + dd * 64 + 8 * k8; const f32x4 w0 = *(const LAS f32x4*)wp, w1 = *(const LAS f32x4*)(wp + 4);
            s += ((w0[0] * bflo(kk.x) + w0[1] * bfhi(kk.x)) + (w0[2] * bflo(kk.y) + w0[3] * bfhi(kk.y))) + ((w1[0] * bflo(kk.z) + w1[1] * bfhi(kk.z)) + (w1[2] * bflo(kk.w) + w1[3] * bfhi(kk.w))); }
        WSP(float, WS_DN)[(((size_t)cidx * 4 + h) * 2 + dd) * 64 + d] = s;
        if (d == 0) WSP(float, WS_BEND)[((size_t)cidx * 4 + h) * 2 + dd] = tab[128 + dd]; }
}
__device__ __forceinline__ void ml_carry_unit(const Ctx& C, int chain) {
    const int dir = chain & 1, h = (chain >> 1) & 3, b = chain >> 3;
    const bf16* DCp = WSP(bf16, WS_DC); bf16* CIN = WSP(bf16, WS_CIN); const float* DN = WSP(float, WS_DN); float* NINp = WSP(float, WS_NIN); const float* BEND = WSP(float, WS_BEND);
    float zz = 0.f; asm volatile("" : "+v"(zz));
    float st[8]; float ns = zz;
#pragma unroll
    for (int j = 0; j < 8; ++j) st[j] = zz;
    const int nl = C.tid & 63;
    size_t idx[4], nidx[4]; u32x4 dv[4], ndv[4]; float be[4], dn[4], nbe[4], ndn[4];
#define MLC_LOAD(S0, IDX, DV, BE, DNV) _Pragma("unroll") for (int k = 0; k < 4; ++k) { const int step = (S0) + k; const int cidx = (S0) == 0 ? 1024 + b * 4 + (dir == 0 ? step : 3 - step) : b * 128 + (dir == 0 ? step - 4 : 131 - step); \
            IDX[k] = ((size_t)cidx * 4 + h) * 2 + dir; DV[k] = *(const u32x4*)(DCp + IDX[k] * 4096 + C.tid * 8); BE[k] = BEND[IDX[k]]; DNV[k] = DN[IDX[k] * 64 + nl]; }
    MLC_LOAD(0, idx, dv, be, dn)
    for (int s0 = 0; s0 < 132; s0 += 4) {
        const int sn = s0 + 4 < 132 ? s0 + 4 : s0;
        MLC_LOAD(sn, nidx, ndv, nbe, ndn)
#pragma unroll
        for (int k = 0; k < 4; ++k) {
            u32x4 o; o.x = pk2(st[0], st[1]); o.y = pk2(st[2], st[3]); o.z = pk2(st[4], st[5]); o.w = pk2(st[6], st[7]);
            *(u32x4*)(CIN + idx[k] * 4096 + C.tid * 8) = o;
            const float dec = __expf(be[k]);
            st[0] = dec * st[0] + bflo(dv[k].x); st[1] = dec * st[1] + bfhi(dv[k].x); st[2] = dec * st[2] + bflo(dv[k].y); st[3] = dec * st[3] + bfhi(dv[k].y);
            st[4] = dec * st[4] + bflo(dv[k].z); st[5] = dec * st[5] + bfhi(dv[k].z); st[6] = dec * st[6] + bflo(dv[k].w); st[7] = dec * st[7] + bfhi(dv[k].w);
            if (C.tid < 64) NINp[idx[k] * 64 + C.tid] = ns;
            ns = dec * ns + dn[k];
        }
#pragma unroll
        for (int k = 0; k < 4; ++k) { idx[k] = nidx[k]; dv[k] = ndv[k]; be[k] = nbe[k]; dn[k] = ndn[k]; }
    }
#undef MLC_LOAD
}
struct MlcIn { u32x4 vv, kk, qq, c0, c1, ogate; f32x4 ng0, ng1; float g_i, g_f, nin; };
__device__ __forceinline__ void mlC_load(const Ctx& C, int l, int cidx, int h, MlcIn& R) {
    const bf16* z1 = WSP(bf16, WS_Z1); const float* gm = WSP(float, WS_GM);
    const int r0 = cidx * 64, w = C.wave, lane = C.lane;
    const bf16* rp = z1 + (size_t)(r0 + lane) * ZP + h * 64 + 8 * w;
    R.qq = *(const u32x4*)(rp + 768); R.kk = *(const u32x4*)(rp + 1024); R.vv = *(const u32x4*)(rp + 1280);
    { const int row = C.tid >> 2, ch = C.tid & 3; const bf16* cp = WSP(bf16, WS_CIN) + (((size_t)cidx * 4 + h) * 2 + (row >> 6)) * 4096 + (row & 63) * 64 + 16 * ch; R.c0 = *(const u32x4*)cp; R.c1 = *(const u32x4*)(cp + 8); }
    R.ogate = *(const u32x4*)(z1 + (size_t)(r0 + (C.tid >> 3)) * ZP + 1536 + h * 64 + (C.tid & 7) * 8);
    const float* ng = INP(22) + l * 256 + h * 64 + (C.tid & 7) * 8; R.ng0 = *(const f32x4*)ng; R.ng1 = *(const f32x4*)(ng + 4);
    const float* gr = gm + (size_t)(r0 + lane) * 16 + (w & 1) * 8 + h; R.g_i = gr[0]; R.g_f = gr[4];
    R.nin = WSP(float, WS_NIN)[(((size_t)cidx * 4 + h) * 2 + ((C.tid >> 6) & 1)) * 64 + lane];
}
__device__ __forceinline__ void mlC_compute(const Ctx& C, int l, int cidx, int h, const MlcIn& R, int par) {
    bf16* z1 = WSP(bf16, WS_Z1);
    LAS unsigned char* base = C.lds + par * 64256;
    LAS float* tab = (LAS float*)base;
    LAS bf16* VT = (LAS bf16*)(base + 2048);
    LAS float* Hs = (LAS float*)(base + 2048 + 8704);
    LAS bf16* Ks = (LAS bf16*)(base + 27392);
    LAS bf16* Qs = (LAS bf16*)(base + 27392 + 9216);
    LAS bf16* Cs = (LAS bf16*)(base + 27392 + 2 * 9216);
    const int r0 = cidx * 64, w = C.wave, lane = C.lane;
    const int dir = w >> 2, eblk = (w >> 1) & 1, tblk = w & 1, c = lane & 31, hh = lane >> 5; const int t = 32 * tblk + c;
    ml_gate_tables(C, tab, R.g_i, R.g_f);
    if (C.tid < 128) tab[384 + C.tid] = R.nin;
    { const unsigned vw[4] = {R.vv.x, R.vv.y, R.vv.z, R.vv.w};
#pragma unroll
      for (int q = 0; q < 4; ++q) { VT[(8 * w + 2 * q) * 68 + lane] = (bf16)(vw[q] & 0xffffu); VT[(8 * w + 2 * q + 1) * 68 + lane] = (bf16)(vw[q] >> 16); }
      *(LAS u32x4*)(Ks + lane * 72 + 8 * w) = R.kk; *(LAS u32x4*)(Qs + lane * 72 + 8 * w) = R.qq;
      const int row = C.tid >> 2, ch = C.tid & 3; *(LAS u32x4*)(Cs + row * 72 + 16 * ch) = R.c0; *(LAS u32x4*)(Cs + row * 72 + 16 * ch + 8) = R.c1; }
    __syncthreads();
    bf16x8 qf[4];
#pragma unroll
    for (int s = 0; s < 4; ++s) qf[s] = *(const LAS bf16x8*)(Qs + t * 72 + 16 * s + 8 * hh);
    const float bct = tab[dir * 192 + t];
    float nq = 0.f;
#pragma unroll
    for (int s = 0; s < 4; ++s) { const u32x4 qw = __builtin_bit_cast(u32x4, qf[s]); const LAS float* np = tab + 384 + dir * 64 + 16 * s + 8 * hh; const f32x4 n0 = *(const LAS f32x4*)np, n1 = *(const LAS f32x4*)(np + 4);
        nq += n0[0] * bflo(qw.x) + n0[1] * bfhi(qw.x) + n0[2] * bflo(qw.y) + n0[3] * bfhi(qw.y) + n1[0] * bflo(qw.z) + n1[1] * bfhi(qw.z) + n1[2] * bflo(qw.w) + n1[3] * bfhi(qw.w); }
    nq += __shfl_xor(nq, 32);
    f32x16 acc, acc2;
#pragma unroll
    for (int i = 0; i < 16; ++i) { acc[i] = 0.f; acc2[i] = 0.f; }
    float dsum = 0.f;
#pragma unroll
    for (int sb = 0; sb < 2; ++sb) {
        f32x16 st;
#pragma unroll
        for (int i = 0; i < 16; ++i) st[i] = 0.f;
#pragma unroll
        for (int s = 0; s < 4; ++s) { const bf16x8 kf = *(const LAS bf16x8*)(Ks + (32 * sb + c) * 72 + 16 * s + 8 * hh); st = mfma32(kf, qf[s], st); }
#pragma unroll
        for (int j = 0; j < 4; ++j) { const f32x4 tv = *(const LAS f32x4*)(tab + dir * 192 + 64 + 32 * sb + 8 * j + 4 * hh);
#pragma unroll
            for (int e = 0; e < 4; ++e) { const int i = 4 * j + e, s = 32 * sb + e + 8 * j + 4 * hh; const bool ok = dir == 0 ? (s <= t) : (s >= t);
                const float wgt = __expf(ok ? bct + tv[e] : -INFINITY); const float p = wgt * st[i]; st[i] = p; dsum += p; } }
#pragma unroll
        for (int s2 = 0; s2 < 2; ++s2) {
            u32x4 pw; pw.x = pk2(st[8 * s2 + 0], st[8 * s2 + 1]); pw.y = pk2(st[8 * s2 + 2], st[8 * s2 + 3]); pw.z = pk2(st[8 * s2 + 4], st[8 * s2 + 5]); pw.w = pk2(st[8 * s2 + 6], st[8 * s2 + 7]);
            const LAS bf16* vp = VT + (32 * eblk + c) * 68 + 32 * sb + 16 * s2 + 4 * hh;
            const u32x2 lo = *(const LAS u32x2*)vp, hi = *(const LAS u32x2*)(vp + 8); u32x4 vw; vw.x = lo.x; vw.y = lo.y; vw.z = hi.x; vw.w = hi.y;
            acc = mfma32(__builtin_bit_cast(bf16x8, vw), __builtin_bit_cast(bf16x8, pw), acc); }
    }
#pragma unroll
    for (int s = 0; s < 4; ++s) { const bf16x8 cf = *(const LAS bf16x8*)(Cs + (dir * 64 + 32 * eblk + c) * 72 + 16 * s + 8 * hh); acc2 = mfma32(cf, qf[s], acc2); }
    dsum += __shfl_xor(dsum, 32);
    const float eb = __expf(bct); const float den = dsum + eb * nq; const float rden = 1.0f / fmaxf(fabsf(den), 1.0f);
    if (dir == 0) {
#pragma unroll
        for (int i = 0; i < 16; ++i) Hs[t * 65 + 32 * eblk + (i & 3) + 8 * (i >> 2) + 4 * hh] = (acc[i] + eb * acc2[i]) * rden; }
    __syncthreads();
    if (dir == 1) {
#pragma unroll
        for (int i = 0; i < 16; ++i) Hs[t * 65 + 32 * eblk + (i & 3) + 8 * (i >> 2) + 4 * hh] += (acc[i] + eb * acc2[i]) * rden; }
    __syncthreads();
    { const int tt = C.tid >> 3, e0 = (C.tid & 7) * 8; float hv[8]; float ss = 0.f;
#pragma unroll
      for (int j = 0; j < 8; ++j) { hv[j] = Hs[tt * 65 + e0 + j]; ss += hv[j] * hv[j]; }
      ss += __shfl_xor(ss, 1); ss += __shfl_xor(ss, 2); ss += __shfl_xor(ss, 4);
      const float rs = 1.0f / sqrtf(ss * (1.0f / 64.0f) + NORM_EPS);
      bf16* rowp = z1 + (size_t)(r0 + tt) * ZP; const unsigned ow[4] = {R.ogate.x, R.ogate.y, R.ogate.z, R.ogate.w};
      const float ng[8] = {R.ng0[0], R.ng0[1], R.ng0[2], R.ng0[3], R.ng1[0], R.ng1[1], R.ng1[2], R.ng1[3]}; unsigned o[4];
#pragma unroll
      for (int q = 0; q < 4; ++q) o[q] = pk2(hv[2 * q] * rs * ng[2 * q] * sigmoidf_(bflo(ow[q])), hv[2 * q + 1] * rs * ng[2 * q + 1] * sigmoidf_(bfhi(ow[q])));
      u32x4 wv; wv.x = o[0]; wv.y = o[1]; wv.z = o[2]; wv.w = o[3];
      *(u32x4*)(rowp + 768 + h * 64 + e0) = wv; }
}
__device__ __forceinline__ void s5_carry_unit(const Ctx& C, int l, int unit) {
    const int x = unit * 512 + C.tid; const int p = x & 63, d = (x >> 6) & 1, g = (x >> 7) & 15, b = x >> 11;
    const float* lp = WSP(float, WS_LP) + ((((size_t)l * 2 + d) * 16 + g) * 64 + p) * 66; const float lr = lp[64], li = lp[65];
    const float* E = WSP(float, WS_E); bf16* A2 = WSP(bf16, WS_A2);
    float sr = 0.f; asm volatile("" : "+v"(sr)); float si = sr;
    size_t row[8], nrow[8]; float er[8], ei[8], ner[8], nei[8];
#define S5C_LOAD(S0, ROW, ER, EI) _Pragma("unroll") for (int k = 0; k < 8; ++k) { const int step = (S0) + k; const int ch = (S0) == 0 ? 2048 + b * 8 + (d == 0 ? step : 7 - step) : b * 256 + (d == 0 ? step - 8 : 263 - step); \
            ROW[k] = (size_t)g * NCH5P + ch; ER[k] = E[ROW[k] * 256 + (d * 2) * 64 + p]; EI[k] = E[ROW[k] * 256 + (d * 2 + 1) * 64 + p]; }
    S5C_LOAD(0, row, er, ei)
    for (int s0 = 0; s0 < 264; s0 += 8) {
        const int sn = s0 + 8 < 264 ? s0 + 8 : s0;
        S5C_LOAD(sn, nrow, ner, nei)
#pragma unroll
        for (int k = 0; k < 8; ++k) {
            A2[row[k] * A2P + 512 + (d * 2) * 64 + p] = f2bf(sr); A2[row[k] * A2P + 512 + (d * 2 + 1) * 64 + p] = f2bf(si);
            const float nr = lr * sr - li * si + er[k], ni = lr * si + li * sr + ei[k]; sr = nr; si = ni;
        }
#pragma unroll
        for (int k = 0; k < 8; ++k) { row[k] = nrow[k]; er[k] = ner[k]; ei[k] = nei[k]; }
    }
#undef S5C_LOAD
}

constexpr int PH_PER_LAYER = 15, PH_FINAL = 3 + 2 * PH_PER_LAYER, N_PHASES = PH_FINAL + 1;

__global__ void __launch_bounds__(512, 2) skel_fwd(Args args) {
    extern __shared__ __attribute__((aligned(16))) unsigned char lds_raw[];
    Ctx C; C.lds = (LAS unsigned char*)lds_raw; C.tid = threadIdx.x; C.lane = C.tid & 63; C.wave = __builtin_amdgcn_readfirstlane(C.tid >> 6); C.G = GRID; C.bid = blockIdx.x;
    C.ap = kargs();
    volatile LAS unsigned* MISC = (volatile LAS unsigned*)(C.lds + MISC_OFF);
    for (int u = C.tid; u < (LDS_BYTES - RING_BYTES) / 4; u += 512) ((LAS unsigned*)(C.lds + RING_BYTES))[u] = 0u;
    __syncthreads();
    if (C.ap->ph_hi - C.ap->ph_lo > 1) (void)xcd_barrier_post((unsigned*)(C.ap->ws + WS_CTL) + CW_BAR, MISC + 8);
#ifndef PHMASK
#define PHMASK 0xFFFFFFFFu
#endif
#define IN(k) (phase_enter(C) && C.ap->ph_lo <= (k) && (k) < C.ap->ph_hi)
#define EN(j) (((PHMASK) >> (j)) & 1u)
#ifndef DBLMASK
#define DBLMASK 0u
#endif
#define REPS(j) ((((DBLMASK) >> (j)) & 1u) ? 2 : 1)
#define SEAM(k) do { if ((k) + 1 < C.ap->ph_hi) { XcdBarrier bar_; bar_.bar = (unsigned*)(C.ap->ws + WS_CTL) + CW_BAR; bar_.x = xb_xcc_id(); bar_.st = (volatile LAS unsigned*)(C.lds + MISC_OFF) + 8; xcd_barrier(bar_); } } while (0)
#define ring (C.lds)
#define modl (WSP(float, WS_MODV) + (size_t)l * 9 * 6144)
#define xlat_in (l == 0 ? INP(0) : (const float*)OUTP)
#define xctx_in (l == 0 ? INP(2) : (const float*)WSP(float, WS_XC))
#define HN WSP(bf16, WS_HN)
#define Z1 WSP(bf16, WS_Z1)

    if (EN(16) && IN(0)) { for (int rep_ = 0; rep_ < REPS(16); ++rep_) pro0(C); SEAM(0); }
    if (EN(17) && IN(1)) { pro1(C); SEAM(1); }
    if (EN(18) && IN(2)) { pro2(C); norm_emit_phase(C, INP(0), INP(2), INP(6), WSP(float, WS_MODV), WSP(bf16, WS_HN), WSP(float, WS_SSQ), MTOT); SEAM(2); }

    for (int l = 0; l < DEPTH; ++l) {
        const int pb = 3 + l * PH_PER_LAYER;
        const int MP = l == 0 ? MTOT : MLAT;


        if (EN(1) && IN(pb + 1)) for (int rep_ = 0; rep_ < REPS(1); ++rep_) {
            pg8::Gemm g{HN, WSP(bf16, WS_WIN) + (size_t)l * NIN * 1024, MTOT, NIN, 1024, 1024, 1024}; PrefOrder S; S.init(MTOT, NIN, C.G, C.bid);
            S.ssq = WSP(float, WS_SSQ) + (size_t)(2 * l) * MTOT; S.shw = WSP(float, WS_SHWI) + (size_t)l * 9 * NIN; S.ldsh = NIN; S.slot = (LAS float*)(C.lds + PREF_OFF);
            EpiWin E{Z1, WSP(bf16, WS_A2), WSP(float, WS_GM), WSP(unsigned char, WS_GATE), (const LAS float*)(C.lds + PREF_OFF), INP(20) + l * 8, INP(21) + l * 8};
            pg8::gemm_phase<EpiWin, PrefOrder, true, true>(ring, g, S, E);
            SEAM(pb + 1);
        }
        if (EN(2) && IN(pb + 2)) for (int rep_ = 0; rep_ < REPS(2); ++rep_) {
            { pg8::Gemm g{WSP(bf16, WS_A2), WSP(bf16, WS_W1) + (size_t)l * 16 * 256 * 512, 16 * NCH5P, 16 * 256, 512, A2P, 512}; GroupOrder S{16, 9, 1, C.G, C.bid, 9};
              EpiS5E E{WSP(float, WS_E)};
              pg8::gemm_phase<EpiS5E, GroupOrder, true, true>(ring, g, S, E); }
            __syncthreads();
            asm volatile("" : "+v"(C.tid), "+v"(C.lane));
            for (int r2_ = 0; r2_ < REPS(12); ++r2_) {
                const int bid_ = C.bid;
                auto unit_of = [&](int k) -> int { if (bid_ >= 144) return k < 4 ? (bid_ - 144) + 112 * k : 448 + (GRID - 1 - bid_) + GRID * (k - 4); return 448 + (GRID - 1 - bid_) + GRID * k; };
                MlaIn cur, nxt; int k = 0, u = unit_of(0); { const int u0 = u < NCHM * 4 ? u : 0; mlA_load(C, u0 >> 2, u0 & 3, cur); }
                while (u < NCHM * 4) { const int un_ = unit_of(k + 1); const int un = un_ < NCHM * 4 ? un_ : u; mlA_load(C, un >> 2, un & 3, nxt); mlA_compute(C, l, u >> 2, u & 3, cur, k & 1); cur = nxt; u = un_; ++k; }
                __syncthreads(); }
            rope_phase(C);
            SEAM(pb + 2);
        }
        if (EN(3) && IN(pb + 3)) for (int rep_ = 0; rep_ < REPS(3); ++rep_) {
            const int natt = 2048 + (l == 0 ? 64 : 0);
            unsigned* qctr = (unsigned*)(C.ap->ws + WS_CTL) + 8192 + 64 * l;
            volatile LAS unsigned* qslot = (volatile LAS unsigned*)(C.lds + RING_BYTES + 64);
            unsigned qn = C.tid == 0 ? __hip_atomic_fetch_add(qctr, 1u, __ATOMIC_RELAXED, __HIP_MEMORY_SCOPE_AGENT) : 0u;
            for (;;) {
                __syncthreads();
                if (C.tid == 0) *qslot = qn;
                __syncthreads();
                const int u = (int)*qslot; if (u >= 96 + natt) break;
                if (C.tid == 0) qn = __hip_atomic_fetch_add(qctr, 1u, __ATOMIC_RELAXED, __HIP_MEMORY_SCOPE_AGENT);
                if (u < 32) s5_carry_unit(C, l, u);
                else if (u < 96) ml_carry_unit(C, u - 32);
                else { const int a = u - 96;
                    if (a < 2048) attn_unit(C, Z1, INP(9) + l * 8, a >> 8, (a >> 7) & 1, (a & 127) * 64, false);
                    else { const int cx = a - 2048; attn_unit(C, Z1, INP(9) + l * 8, cx >> 3, (cx >> 2) & 1, (cx & 3) * 64, true); } }
            }
            SEAM(pb + 3);
        }
        if (EN(4) && IN(pb + 4)) for (int rep_ = 0; rep_ < REPS(4); ++rep_) {
            { pg8::Gemm g{WSP(bf16, WS_A2), WSP(bf16, WS_W2) + (size_t)l * 16 * 512 * 768, 16 * NCH5P, 16 * 512, 768, A2P, 768}; GroupOrder S{16, l == 0 ? 9 : 8, 2, C.G, C.bid, 9};
              EpiS5Y E{WSP(bf16, WS_YPRE)};
              pg8::gemm_phase<EpiS5Y, GroupOrder, true, true>(ring, g, S, E); }
            __syncthreads();
            asm volatile("" : "+v"(C.tid), "+v"(C.lane));
            const int nml = (l == 0 ? NCHM : 1024) * 4;
            { const int R = l == 0 ? 6 : 0; const int bid_ = C.bid;
              auto unit_of = [&](int k) -> int { if (bid_ >= 32) return k < R ? (bid_ - 32) + 224 * k : R * 224 + (GRID - 1 - bid_) + GRID * (k - R); return R * 224 + (GRID - 1 - bid_) + GRID * k; };
              MlcIn cur, nxt; int k = 0, u = unit_of(0); { const int u0 = u < nml ? u : 0; mlC_load(C, l, u0 >> 2, u0 & 3, cur); }
              while (u < nml) { const int un_ = unit_of(k + 1); const int un = un_ < nml ? un_ : u; mlC_load(C, l, un >> 2, un & 3, nxt); mlC_compute(C, l, u >> 2, u & 3, cur, k & 1); cur = nxt; u = un_; ++k; } }
            SEAM(pb + 4);
        }
        if (EN(5) && IN(pb + 5)) for (int rep_ = 0; rep_ < REPS(5); ++rep_) {
            pg8::Gemm g{WSP(bf16, WS_YPRE), WSP(bf16, WS_WGLU) + (size_t)l * 256 * 256, MP, 256, 256, 256, 256}; pg8::StaticOrder S; S.init(MP, 256, C.G, C.bid);
            EpiGlu E{WSP(bf16, WS_YPRE), Z1 + 512, INP(19) + l * 256, ZP};
            pg8::gemm_phase<EpiGlu, pg8::StaticOrder, true, true>(ring, g, S, E);
            SEAM(pb + 5);
        }
        if (EN(6) && IN(pb + 6)) for (int rep_ = 0; rep_ < REPS(6); ++rep_) {
            pg8::Gemm g{Z1, WSP(bf16, WS_WBA) + (size_t)l * 1024 * 1024, MP, 1024, 1024, ZP, 1024}; pg8::StaticOrder S; S.init(MP, 2048, C.G, C.bid);
            EpiMergeF E{HN, WSP(unsigned char, WS_GATE)};
            pg8::gemm_phase<EpiMergeF, pg8::StaticOrder, true, true, true>(ring, g, S, E);
            SEAM(pb + 6);
        }
        if (EN(7) && IN(pb + 7)) for (int rep_ = 0; rep_ < REPS(7); ++rep_) {
            { pg8::Gemm g{HN, WSP(bf16, WS_WOUT) + (size_t)l * 1024 * 1024, MLAT, 1024, 1024, 1024, 1024}; pg8::StaticOrder S; S.init(MLAT, 1024, C.G, C.bid);
              EpiResid<true> E{xlat_in, xctx_in, OUTP, WSP(float, WS_XC), modl + 2048, 0, WSP(bf16, WS_HN2), WSP(float, WS_GAM) + (size_t)(l * 2 + 1) * 9 * 1024, WSP(float, WS_SSQ) + (size_t)(2 * l + 1) * MTOT};
              pg8::gemm_phase<EpiResid<true>, pg8::StaticOrder, true, true>(ring, g, S, E); }
            if (l == 0) {
                asm volatile("" : "+v"(C.tid), "+v"(C.lane));
                pg8::Gemm g{HN + (size_t)MLAT * 1024, WSP(bf16, WS_WOUT) + (size_t)l * 1024 * 1024, MCTX, 1024, 1024, 1024, 1024}; pg8::StaticOrder S; S.init(MCTX, 2048, C.G, C.bid);
                EpiResid<true, true> E{xlat_in, xctx_in, OUTP, WSP(float, WS_XC), modl + 2048, MLAT, WSP(bf16, WS_HN2), WSP(float, WS_GAM) + (size_t)(l * 2 + 1) * 9 * 1024, WSP(float, WS_SSQ) + (size_t)(2 * l + 1) * MTOT};
                pg8::gemm_phase<EpiResid<true, true>, pg8::StaticOrder, true, true, true>(ring, g, S, E); }
            SEAM(pb + 7);
        }
        if (EN(9) && IN(pb + 9)) {
            pg8::Gemm g{WSP(bf16, WS_HN2), WSP(bf16, WS_WUP) + (size_t)l * NUP * 1024, MP, NUP, 1024, 1024, 1024}; PrefOrder S; S.init(MP, NUP, C.G, C.bid);
            S.ssq = WSP(float, WS_SSQ) + (size_t)(2 * l + 1) * MTOT; S.shw = WSP(float, WS_SHWU) + (size_t)l * 9 * NUP; S.ldsh = NUP; S.slot = (LAS float*)(C.lds + PREF_OFF);
            EpiUpConv E{WSP(bf16, WS_ACT), WSP(float, WS_RAW), (const LAS float*)(C.lds + PREF_OFF), INP(28) + (size_t)l * 3 * NUP, INP(29) + (size_t)l * NUP, (LAS float*)(C.lds + RING_BYTES + 1024)};
            pg8::gemm_phase<EpiUpConv, PrefOrder, true, true>(ring, g, S, E);
            SEAM(pb + 9);
        }
        if (EN(10) && IN(pb + 10)) { seam_phase(C, WSP(float, WS_RAW), WSP(bf16, WS_ACT), INP(28) + (size_t)l * 3 * NUP, INP(29) + (size_t)l * NUP, MP / 256); SEAM(pb + 10); }
        if (EN(11) && IN(pb + 11)) {
            pg8::Gemm g{WSP(bf16, WS_ACT), WSP(bf16, WS_WDN) + (size_t)l * 1024 * DFF, MLAT, 1024, DFF, DFF, DFF}; pg8::StaticOrder S; S.init(MLAT, 1024, C.G, C.bid);
            if (l == 0) { { EpiResid<true> E{OUTP, WSP(float, WS_XC), OUTP, WSP(float, WS_XC), modl + 5120, 0, HN, WSP(float, WS_GAM) + (size_t)2 * 9 * 1024, WSP(float, WS_SSQ) + (size_t)2 * MTOT};
                  pg8::gemm_phase<EpiResid<true>, pg8::StaticOrder, true, true>(ring, g, S, E); }
                asm volatile("" : "+v"(C.tid), "+v"(C.lane));
                pg8::Gemm g2{WSP(bf16, WS_ACT) + (size_t)MLAT * DFF, WSP(bf16, WS_WDN) + (size_t)l * 1024 * DFF, MCTX, 1024, DFF, DFF, DFF}; pg8::StaticOrder S2; S2.init(MCTX, 2048, C.G, C.bid);
                EpiResid<true, true> E2{OUTP, WSP(float, WS_XC), OUTP, WSP(float, WS_XC), modl + 5120, MLAT, HN, WSP(float, WS_GAM) + (size_t)2 * 9 * 1024, WSP(float, WS_SSQ) + (size_t)2 * MTOT};
                pg8::gemm_phase<EpiResid<true, true>, pg8::StaticOrder, true, true, true>(ring, g2, S2, E2); }
            else { EpiResid<false> E{OUTP, WSP(float, WS_XC), OUTP, WSP(float, WS_XC), modl + 5120, 0, nullptr, nullptr, nullptr};
                pg8::gemm_phase<EpiResid<false>, pg8::StaticOrder, true, true>(ring, g, S, E); }
            SEAM(pb + 11);
        }
    }
    if (IN(PH_FINAL)) final_norm_phase(C, OUTP, INP(31));
#undef IN
#undef SEAM
#undef ring
#undef modl
#undef xlat_in
#undef xctx_in
#undef HN
#undef Z1
}


#ifndef MK_SPLIT
#define MK_SPLIT 0
#endif
extern "C" void kernel_launch(void* const* d_in, const int* in_sizes, int n_in, void* d_out, int out_size, void* d_ws, size_t ws_size, hipStream_t stream) {
    static int grid = 0;
    if (grid == 0) {
        if (n_in != 32 || out_size != MLAT * DM || ws_size < WS_END) { fprintf(stderr, "kernel_launch: unexpected problem (n_in %d, out %d, ws %zu, need %zu)\n", n_in, out_size, ws_size, (size_t)WS_END); grid = -1; return; }
        int dev = 0, cus = 0, per_cu = 0;
        if (hipGetDevice(&dev) != hipSuccess || hipDeviceGetAttribute(&cus, hipDeviceAttributeMultiprocessorCount, dev) != hipSuccess) { grid = -1; return; }
        if (hipFuncSetAttribute((const void*)skel_fwd, hipFuncAttributeMaxDynamicSharedMemorySize, LDS_BYTES) != hipSuccess) { fprintf(stderr, "kernel_launch: hipFuncSetAttribute failed\n"); grid = -1; return; }
        if (hipOccupancyMaxActiveBlocksPerMultiprocessor(&per_cu, (const void*)skel_fwd, 512, LDS_BYTES) != hipSuccess || per_cu < 1) fprintf(stderr, "kernel_launch: occupancy query reports %d\n", per_cu);
        (void)hipGetLastError();
        if (cus < GRID) { fprintf(stderr, "kernel_launch: built for a %d-CU device, found %d CUs\n", GRID, cus); grid = -1; return; }
        grid = GRID;
    }
    if (grid < 0) return;
    (void)hipMemsetAsync((char*)d_ws + WS_CTL, 0, ZERO_BYTES, stream);
    Args a{};
    for (int i = 0; i < 32; ++i) a.in[i] = (const float*)d_in[i];
    a.out = (float*)d_out; a.ws = (unsigned char*)d_ws;
#if MK_SPLIT
    for (int ph = 0; ph < N_PHASES; ++ph) { a.ph_lo = ph; a.ph_hi = ph + 1; hipLaunchKernelGGL(skel_fwd, dim3(grid), dim3(512), LDS_BYTES, stream, a); }
#else
    a.ph_lo = 0; a.ph_hi = N_PHASES; hipLaunchKernelGGL(skel_fwd, dim3(grid), dim3(512), LDS_BYTES, stream, a);
#endif
}
```

```cpp
#include <hip/hip_runtime.h>
#include <cstdio>
#include <cstdint>
#include <type_traits>
namespace pg8 {
#define PG8_LAS __attribute__((address_space(3)))
typedef unsigned short bf16_t;
typedef short bf16x8 __attribute__((ext_vector_type(8)));
typedef float f32x4 __attribute__((ext_vector_type(4)));
typedef unsigned u32x4 __attribute__((ext_vector_type(4)));
constexpr int BM = 256, BK = 64, HALF = 128, HTB = HALF * BK * 2  , STAGE_BYTES = 8 * HTB, NXCD = 8, WGM = 4;

__host__ __device__ __forceinline__ int lds_byte(int r, int c) { const int st = (r >> 4) * 2 + (c >> 5), rr = r & 15, cc = c & 31, ob = rr * 64 + cc * 2; return st * 1024 + (ob ^ (((ob >> 9) & 1) << 5)); }
__host__ __device__ __forceinline__ void stage_rc(int b, int& R, int& C) { const int st = b / 1024, sb = b % 1024, swz = sb ^ (((sb >> 9) & 1) << 5); R = (st >> 1) * 16 + swz / 64; C = (st & 1) * 32 + (swz % 64) / 2; }
__host__ __device__ __forceinline__ int perm32(int rho) { const int n = rho >> 4, i = rho & 15; return 8 * (i >> 2) + 4 * n + (i & 3); }

struct Unit { int pm, pn, seq; };
struct Gemm { const bf16_t* A; const bf16_t* Bt; int M, N, K, lda, ldb; };

struct StaticOrder {
    int nM, nN, nwg, G, c;
    __host__ __device__ void init(int M, int N, int G_, int c_) { nM = M / BM; nN = N / BM; nwg = nM * nN; G = G_; c = c_; }
    __host__ __device__ bool next(int i, Unit& u) const {
        const long L = (long)i * G + c; if (L >= nwg) return false;
        int wgid = (int)L; { const int q = nwg / NXCD, r = nwg % NXCD, xcd = wgid % NXCD, off = wgid / NXCD; wgid = (xcd < r ? xcd * (q + 1) : r * (q + 1) + (xcd - r) * q) + off; }
        const int nig = WGM * nN, gid = wgid / nig, fm = gid * WGM, gsz = WGM;
        u.pm = fm + ((wgid % nig) % gsz); u.pn = (wgid % nig) / gsz; u.seq = i; return true;
    }
    __device__ __forceinline__ void a_ready(const Unit&) const {}
    __device__ __forceinline__ void done(const Unit&) const {}
};


struct NoState {};
template <class T, class = void> struct epi_state { typedef NoState type; static constexpr bool has = false; };
template <class T> struct epi_state<T, std::void_t<typename T::State>> { typedef typename T::State type; static constexpr bool has = true; };
template <class T, class = void> struct epi_nseg { static constexpr int value = 1; };
template <class T> struct epi_nseg<T, std::void_t<typename T::State>> { static constexpr int value = T::NSEG; };
template <class Epi, class Sched, bool ALIGN_EPI = false, bool SP2 = false, bool NHALF = false>
__device__ __forceinline__ void gemm_phase(PG8_LAS unsigned char* lds, const Gemm g, const Sched& S, const Epi& E) {
    int tid_ = threadIdx.x; asm volatile("" : "+v"(tid_));
    const int tid = tid_, wid = __builtin_amdgcn_readfirstlane(tid >> 6), lane = tid & 63, wr = wid >> 2, wc = wid & 3, fr = lane & 15, fq = lane >> 4;
    const int K = g.K, nt = K / BK;
    unsigned voffA[2], voffB[2];
#pragma unroll
    for (int i = 0; i < 2; ++i) { int R, C; stage_rc(tid * 16 + i * 8192, R, C); const int Rb = Epi::PERM ? ((R & ~31) + perm32(R & 31)) : R;
        voffA[i] = (unsigned)(R * g.lda + C) * 2u; voffB[i] = (unsigned)(Rb * g.ldb + C) * 2u; }
    const size_t kstep = (size_t)(BK * 2);
    const size_t hstepA = (size_t)HALF * g.lda * 2, hstepB = (size_t)HALF * g.ldb * 2;
    const size_t tstepA = 2 * hstepA, tstepB = 2 * hstepB;
    const size_t bstep = NHALF ? hstepB : tstepB, bh = NHALF ? 0 : hstepB;
    static_assert(!NHALF || SP2, "NHALF is implemented for the SP2 loop");
    const unsigned ldsw = (unsigned)wid * 1024u;
    const int aoff = lds_byte(wr * 64 + fr, fq * 8), boff = lds_byte(wc * 32 + fr, fq * 8);
#define PG8_SA(b, h) (((b) * 2 + (h)) * HTB)
#define PG8_SB(b, h) ((4 + (b) * 2 + (h)) * HTB)
#define PG8_STAGE(bufoff, gbase, voff) do { _Pragma("unroll") for (int _i = 0; _i < 2; ++_i) \
        __builtin_amdgcn_global_load_lds((const unsigned*)((const char*)(gbase) + (voff)[_i]), (PG8_LAS unsigned*)(lds + (bufoff) + ldsw + _i * 8192), 16, 0, 0); } while (0)
#define PG8_STAGE_NT(bufoff, gbase, voff) do { _Pragma("unroll") for (int _i = 0; _i < 2; ++_i) \
        __builtin_amdgcn_global_load_lds((const unsigned*)((const char*)(gbase) + (voff)[_i]), (PG8_LAS unsigned*)(lds + (bufoff) + ldsw + _i * 8192), 16, 0, 0); } while (0)
#define PG8_LDA(dst, b, h) do { _Pragma("unroll") for (int m = 0; m < 4; ++m) _Pragma("unroll") for (int k = 0; k < 2; ++k) dst[m][k] = *(const PG8_LAS bf16x8*)(lds + PG8_SA(b, h) + aoff + m * 2048 + k * 1024); } while (0)
#define PG8_LDB(dst, b, h) do { _Pragma("unroll") for (int n = 0; n < 2; ++n) _Pragma("unroll") for (int k = 0; k < 2; ++k) dst[n][k] = *(const PG8_LAS bf16x8*)(lds + PG8_SB(b, h) + boff + n * 2048 + k * 1024); } while (0)
#define PG8_MMA(ai, bj, At, Bt) do { __builtin_amdgcn_s_setprio(1); _Pragma("unroll") for (int m = 0; m < 4; ++m) _Pragma("unroll") for (int n = 0; n < 2; ++n) _Pragma("unroll") for (int k = 0; k < 2; ++k) \
        acc[ai][bj][m][n] = __builtin_amdgcn_mfma_f32_16x16x32_bf16(Bt[n][k], At[m][k], acc[ai][bj][m][n], 0, 0, 0); __builtin_amdgcn_s_setprio(0); } while (0)
#define PG8_WAIT_V(n) asm volatile("s_waitcnt vmcnt(" #n ")" ::: "memory")
#define PG8_WAIT_L(n) asm volatile("s_waitcnt lgkmcnt(" #n ")" ::: "memory")
#define PG8_BAR __builtin_amdgcn_s_barrier()
#define PG8_SCHED __builtin_amdgcn_sched_barrier(0)
    Unit cur, nxt; int ui = 0;
    if (!S.next(0, cur)) return;
    f32x4 acc[2][2][4][2];
    typename epi_state<Epi>::type est;
#pragma unroll
    for (int a = 0; a < 2; ++a)
#pragma unroll
        for (int b = 0; b < 2; ++b)
#pragma unroll
            for (int m = 0; m < 4; ++m)
#pragma unroll
                for (int n = 0; n < 2; ++n) acc[a][b][m][n] = (f32x4){0.f, 0.f, 0.f, 0.f};
    bf16x8 At[4][2], B0[2][2], B1[2][2];
    const char* cA = (const char*)g.A + (size_t)cur.pm * tstepA; const char* cB = (const char*)g.Bt + (size_t)cur.pn * bstep;
    S.a_ready(cur);
    if constexpr (SP2) {
        PG8_STAGE_NT(PG8_SB(0, 0), cB, voffB); PG8_STAGE_NT(PG8_SB(0, 1), cB + bh, voffB); PG8_STAGE(PG8_SA(0, 0), cA, voffA); PG8_STAGE(PG8_SA(0, 1), cA + hstepA, voffA);
        if (wr == 1) PG8_BAR;
        PG8_WAIT_V(2); PG8_BAR;
        PG8_STAGE_NT(PG8_SB(1, 0), cB + kstep, voffB); PG8_STAGE(PG8_SA(1, 0), cA + kstep, voffA); PG8_STAGE_NT(PG8_SB(1, 1), cB + bh + kstep, voffB);
        PG8_WAIT_V(6); PG8_BAR;
    } else {
        PG8_STAGE_NT(PG8_SB(0, 0), cB, voffB); PG8_STAGE(PG8_SA(0, 0), cA, voffA); PG8_STAGE_NT(PG8_SB(0, 1), cB + bh, voffB); PG8_STAGE(PG8_SA(0, 1), cA + hstepA, voffA);
        if (wr == 1) PG8_BAR;
        PG8_WAIT_V(4); PG8_BAR;
        PG8_STAGE_NT(PG8_SB(1, 0), cB + kstep, voffB); PG8_STAGE(PG8_SA(1, 0), cA + kstep, voffA); PG8_STAGE_NT(PG8_SB(1, 1), cB + bh + kstep, voffB);
        PG8_WAIT_V(6); PG8_BAR;
    }
    for (;;) {
        const bool has_next = S.next(ui + 1, nxt);
        const char* nA = has_next ? (const char*)g.A + (size_t)nxt.pm * tstepA : cA; const char* nB = has_next ? (const char*)g.Bt + (size_t)nxt.pn * bstep : cB;
        int t = 0;
        constexpr int NSEG = epi_nseg<Epi>::value;
        if constexpr (epi_state<Epi>::has) E.init(est);
        for (int seg = 0; seg < NSEG; ++seg) {
        int tend = nt; if constexpr (epi_state<Epi>::has) { tend = E.seg_end(seg); E.seg_open(seg, est, cur, wr, wc, fr, fq); }
#pragma nounroll
        for (; t < tend; t += 2) {
            const bool last = (t == nt - 2);
            const char* a1 = cA + (size_t)(t + 1) * kstep;
            const char* a2 = last ? nA : cA + (size_t)(t + 2) * kstep; const char* b2 = last ? nB : cB + (size_t)(t + 2) * kstep;
            const char* a3 = a2 + kstep; const char* b3 = b2 + kstep;
            if (last && has_next) S.a_ready(nxt);
            if constexpr (SP2) {
            PG8_LDB(B0, 0, 0); if constexpr (!NHALF) PG8_LDB(B1, 0, 1); PG8_SCHED; PG8_LDA(At, 0, 0); PG8_STAGE(PG8_SA(1, 1), a1 + hstepA, voffA);
            PG8_WAIT_V(8); PG8_WAIT_L(0); PG8_BAR; PG8_MMA(0, 0, At, B0); if constexpr (!NHALF) PG8_MMA(0, 1, At, B1); PG8_BAR; PG8_SCHED;
            PG8_LDA(At, 0, 1); PG8_STAGE_NT(PG8_SB(0, 0), b2, voffB); PG8_STAGE_NT(PG8_SB(0, 1), b2 + bh, voffB); PG8_STAGE(PG8_SA(0, 0), a2, voffA);
            PG8_WAIT_V(8); PG8_WAIT_L(0); PG8_BAR; PG8_MMA(1, 0, At, B0); if constexpr (!NHALF) PG8_MMA(1, 1, At, B1); PG8_BAR; PG8_SCHED;
            PG8_LDB(B0, 1, 0); if constexpr (!NHALF) PG8_LDB(B1, 1, 1); PG8_SCHED; PG8_LDA(At, 1, 0); PG8_STAGE(PG8_SA(0, 1), a2 + hstepA, voffA);
            PG8_WAIT_V(8); PG8_WAIT_L(0); PG8_BAR; PG8_MMA(0, 0, At, B0); if constexpr (!NHALF) PG8_MMA(0, 1, At, B1); PG8_BAR; PG8_SCHED;
            PG8_LDA(At, 1, 1); PG8_STAGE_NT(PG8_SB(1, 0), b3, voffB); PG8_STAGE_NT(PG8_SB(1, 1), b3 + bh, voffB); PG8_STAGE(PG8_SA(1, 0), a3, voffA);
            PG8_WAIT_V(8); PG8_WAIT_L(0); PG8_BAR; PG8_MMA(1, 0, At, B0); if constexpr (!NHALF) PG8_MMA(1, 1, At, B1); PG8_BAR; PG8_SCHED;
            } else {
            PG8_LDB(B0, 0, 0); PG8_SCHED; PG8_LDA(At, 0, 0); PG8_STAGE(PG8_SA(1, 1), a1 + hstepA, voffA);
            PG8_WAIT_L(8); PG8_BAR; PG8_WAIT_L(0); PG8_MMA(0, 0, At, B0); PG8_BAR; PG8_SCHED;
            PG8_LDB(B1, 0, 1); PG8_STAGE_NT(PG8_SB(0, 0), b2, voffB);
            PG8_BAR; PG8_WAIT_L(0); PG8_MMA(0, 1, At, B1); PG8_BAR;
            PG8_LDA(At, 0, 1); PG8_STAGE(PG8_SA(0, 0), a2, voffA);
            PG8_BAR; PG8_WAIT_L(0); PG8_MMA(1, 0, At, B0); PG8_BAR; PG8_SCHED;
            PG8_STAGE_NT(PG8_SB(0, 1), b2 + bh, voffB);
            PG8_WAIT_V(6); PG8_BAR; PG8_MMA(1, 1, At, B1); PG8_BAR;
            PG8_LDB(B0, 1, 0); PG8_SCHED; PG8_LDA(At, 1, 0); PG8_STAGE(PG8_SA(0, 1), a2 + hstepA, voffA);
            PG8_WAIT_L(8); PG8_BAR; PG8_WAIT_L(0); PG8_MMA(0, 0, At, B0); PG8_BAR; PG8_SCHED;
            PG8_LDB(B1, 1, 1); PG8_STAGE_NT(PG8_SB(1, 0), b3, voffB);
            PG8_BAR; PG8_WAIT_L(0); PG8_MMA(0, 1, At, B1); PG8_BAR;
            PG8_LDA(At, 1, 1); PG8_STAGE(PG8_SA(1, 0), a3, voffA);
            PG8_BAR; PG8_WAIT_L(0); PG8_MMA(1, 0, At, B0); PG8_BAR; PG8_SCHED;
            PG8_STAGE_NT(PG8_SB(1, 1), b3 + bh, voffB);
            PG8_WAIT_V(6); PG8_BAR; PG8_MMA(1, 1, At, B1); PG8_BAR;
            }
        }
        if constexpr (epi_state<Epi>::has) E.seg_close(seg, acc, est);
        }
        if constexpr (ALIGN_EPI) { if (wr == 0) PG8_BAR; }
        if constexpr (!Epi::AFTER_DRAIN) { if constexpr (epi_state<Epi>::has) E.finish(acc, est, cur, wr, wc, fr, fq); else E(acc, cur, wr, wc, fr, fq); S.done(cur); }
        if (!has_next) break;
#pragma unroll
        for (int a = 0; a < 2; ++a)
#pragma unroll
            for (int b = 0; b < 2; ++b)
#pragma unroll
                for (int m = 0; m < 4; ++m)
#pragma unroll
                    for (int n = 0; n < 2; ++n) acc[a][b][m][n] = (f32x4){0.f, 0.f, 0.f, 0.f};
        cur = nxt; cA = nA; cB = nB; ++ui;
        if constexpr (ALIGN_EPI) { if (wr == 1) PG8_BAR; }
    }
    PG8_WAIT_V(0);
    if constexpr (!ALIGN_EPI) { if (wr == 0) PG8_BAR; }
    PG8_BAR;
    if constexpr (Epi::AFTER_DRAIN) { E.fused(acc, cur, wr, wc, fr, fq, lds, wid, lane); S.done(cur); }
#undef PG8_SA
#undef PG8_SB
#undef PG8_STAGE
#undef PG8_STAGE_NT
#undef PG8_LDA
#undef PG8_LDB
#undef PG8_MMA
#undef PG8_WAIT_V
#undef PG8_WAIT_L
#undef PG8_BAR
#undef PG8_SCHED
}
}

constexpr int NB = 8, SEQ = 8192, DM = 1024, NCTX = 256, DEPTH = 2;
constexpr int MLAT = NB * SEQ, MCTX = NB * NCTX, MTOT = MLAT + MCTX;
constexpr int NIN = 5376;
constexpr int ZP = 1792;
constexpr int DFF = 2816, NUP = 2 * DFF;
constexpr int S5T = 32, NCH5 = MTOT / S5T, NCH5P = 2304, A2P = 768;
constexpr int NCHM = MTOT / 64;
constexpr int MH1 = 32768;
constexpr float NORM_EPS = 1e-6f;

constexpr size_t al256(size_t x) { return (x + 255) & ~(size_t)255; }
constexpr size_t WS_CTL = 0, CTL_BYTES = 1u << 20;
constexpr size_t WS_SSQ  = WS_CTL + CTL_BYTES;
constexpr size_t ZERO_BYTES = 65536;
constexpr size_t WS_MODP = WS_SSQ + al256((size_t)4 * MTOT * 4);
constexpr size_t WS_MODV = WS_MODP + al256((size_t)2 * 16 * 9 * 6144 * 4);
constexpr size_t WS_ROPE = WS_MODV + al256((size_t)2 * 9 * 6144 * 4);
constexpr size_t WS_LP   = WS_ROPE + al256((size_t)128 * 16 * 2 * 4);
constexpr size_t WS_BB   = WS_LP + al256((size_t)2 * 2 * 16 * 64 * 33 * 2 * 4);
constexpr size_t WS_KD   = WS_BB + al256((size_t)2 * 2 * 16 * 64 * 16 * 2 * 4);
constexpr size_t WS_GAM  = WS_KD + al256((size_t)2 * 16 * 2 * 32 * 256 * 4);
constexpr size_t WS_SHWI = WS_GAM + al256((size_t)2 * 2 * 9 * 1024 * 4);
constexpr size_t WS_SHWU = WS_SHWI + al256((size_t)2 * 9 * NIN * 4);
constexpr size_t WS_WIN  = WS_SHWU + al256((size_t)2 * 9 * NUP * 4);
constexpr size_t WS_WBA  = WS_WIN + (size_t)2 * NIN * 1024 * 2;
constexpr size_t WS_WBS  = WS_WBA + (size_t)2 * 1024 * 512 * 2;
constexpr size_t WS_WBM  = WS_WBS + (size_t)2 * 1024 * 256 * 2;
constexpr size_t WS_WOUT = WS_WBM + (size_t)2 * 1024 * 256 * 2;
constexpr size_t WS_WUP  = WS_WOUT + (size_t)2 * 1024 * 1024 * 2;
constexpr size_t WS_WDN  = WS_WUP + (size_t)2 * NUP * 1024 * 2;
constexpr size_t WS_WGLU = WS_WDN + (size_t)2 * 1024 * DFF * 2;
constexpr size_t WS_W1   = WS_WGLU + (size_t)2 * 256 * 256 * 2;
constexpr size_t WS_W2   = WS_W1 + (size_t)2 * 16 * 256 * 512 * 2;
constexpr size_t WS_XC   = WS_W2 + (size_t)2 * 16 * 512 * 768 * 2;
constexpr size_t WS_HN   = WS_XC + (size_t)MCTX * DM * 4;
constexpr size_t WS_R    = WS_HN + (size_t)MTOT * DM * 2;
constexpr size_t WS_Z1   = WS_R;
constexpr size_t WS_A2   = WS_Z1 + (size_t)MTOT * ZP * 2;
constexpr size_t WS_GM   = WS_A2 + (size_t)16 * NCH5P * A2P * 2;
constexpr size_t WS_GATE = WS_GM + (size_t)MTOT * 16 * 4;
constexpr size_t WS_YS   = WS_GATE + (size_t)MTOT * 3072;
constexpr size_t WS_YPRE = WS_YS + (size_t)MTOT * 256 * 2;
constexpr size_t WS_E    = WS_YPRE + (size_t)MTOT * 256 * 2;
constexpr size_t WS_DC   = WS_E + (size_t)16 * NCH5P * 256 * 4;
constexpr size_t WS_CIN  = WS_DC + (size_t)NCHM * 8 * 4096 * 2;
constexpr size_t WS_DN   = WS_CIN + (size_t)NCHM * 8 * 4096 * 2;
constexpr size_t WS_NIN  = WS_DN + (size_t)NCHM * 8 * 64 * 4;
constexpr size_t WS_BEND = WS_NIN + (size_t)NCHM * 8 * 64 * 4;
constexpr size_t WS_REND = WS_BEND + al256((size_t)NCHM * 8 * 4);
constexpr size_t WS_ACT  = WS_R;
constexpr size_t WS_RAW  = WS_ACT + (size_t)MTOT * DFF * 2;
constexpr size_t WS_FEND = WS_RAW + (size_t)(MTOT / 256) * 4 * NUP * 4;
constexpr size_t WS_HN2  = WS_FEND;
static_assert(WS_HN2 + (size_t)MTOT * DM * 2 <= WS_REND, "HN2 placement");
constexpr size_t WS_END  = WS_REND > WS_FEND ? WS_REND : WS_FEND;
static_assert(WS_END <= ((size_t)1 << 30), "d_ws map exceeds 1 GiB");
static_assert(WS_Z1 % 256 == 0 && WS_A2 % 256 == 0 && WS_HN % 256 == 0 && WS_E % 256 == 0 && WS_DC % 256 == 0 && WS_RAW % 256 == 0 && WS_HN2 % 256 == 0 && WS_WIN % 256 == 0, "alignment");

constexpr int CW_BAR = 4096;

constexpr int RING_BYTES = 131072, MISC_OFF = RING_BYTES + 320, PREF_OFF = RING_BYTES + 10240, LDS_BYTES = 147456;

#define LAS __attribute__((address_space(3)))
typedef unsigned short bf16;
typedef short bf16x8 __attribute__((ext_vector_type(8)));
typedef short s16x4 __attribute__((ext_vector_type(4)));
typedef float f32x4 __attribute__((ext_vector_type(4)));
typedef float f32x16 __attribute__((ext_vector_type(16)));
typedef float f32x8 __attribute__((ext_vector_type(8)));
typedef unsigned u32x4 __attribute__((ext_vector_type(4)));
typedef unsigned u32x2 __attribute__((ext_vector_type(2)));

typedef float f32x2_t __attribute__((ext_vector_type(2))); typedef __bf16 bf16x2_t __attribute__((ext_vector_type(2)));
__device__ __forceinline__ unsigned pk2(float lo, float hi) { f32x2_t v = {lo, hi}; bf16x2_t b = __builtin_convertvector(v, bf16x2_t); return __builtin_bit_cast(unsigned, b); }
__device__ __forceinline__ float bflo(unsigned w) { return __uint_as_float(w << 16); }
__device__ __forceinline__ float bfhi(unsigned w) { return __uint_as_float(w & 0xffff0000u); }
__device__ __forceinline__ float bf2f(bf16 h) { return __uint_as_float(((unsigned)h) << 16); }
__device__ __forceinline__ bf16 f2bf(float f) { return (bf16)(pk2(f, 0.f) & 0xffffu); }
__device__ __forceinline__ float sigmoidf_(float x) { return __builtin_amdgcn_rcpf(1.0f + __expf(-x)); }
__device__ __forceinline__ float wave_sum(float v) {
#pragma unroll
    for (int o = 1; o < 64; o <<= 1) v += __shfl_xor(v, o);
    return v;
}

#define XB_TMO      128
#define XB_XCNT(j)  (256  + 64 * (j))
#define XB_XSUB(j)  (1280 + 64 * (j))
#define XB_XGEN(j)  (2304 + 64 * (j))
#define XB_TOP      3328
#define XB_TOPGEN   3392
#define XCD_BAR_WORDS 3456
#define XB_SPIN_CAP (1u << 18)
__device__ __forceinline__ unsigned xb_ld(unsigned* p)              { return __hip_atomic_load(p, __ATOMIC_RELAXED, __HIP_MEMORY_SCOPE_AGENT); }
__device__ __forceinline__ unsigned xb_add(unsigned* p, unsigned v) { return __hip_atomic_fetch_add(p, v, __ATOMIC_RELAXED, __HIP_MEMORY_SCOPE_AGENT); }
__device__ __forceinline__ unsigned xb_xcc_id() { return (unsigned)__builtin_amdgcn_s_getreg((3 << 11) | 20) & 0xFu; }
#define XB_SPIN(cond, bar) do { unsigned _sp = 0; while (cond) { __builtin_amdgcn_s_sleep(1); \
    if ((++_sp & 255u) == 0u) { if (xb_ld(&(bar)[XB_TMO])) break; if (_sp > XB_SPIN_CAP) { atomicAdd(&(bar)[XB_TMO], 1u); break; } } } } while (0)
struct XcdBarrier { unsigned* bar; unsigned x; volatile LAS unsigned* st; };
__device__ __forceinline__ XcdBarrier xcd_barrier_post(unsigned* bar, volatile LAS unsigned* st) {
    XcdBarrier b; b.bar = bar; b.x = xb_xcc_id(); b.st = st;
    if (threadIdx.x == 0) (void)xb_add(&bar[XB_XCNT(b.x)], 1u);
    return b;
}
__device__ __forceinline__ void xcd_barrier_complete(unsigned* bar, unsigned x, unsigned& nloc, unsigned& nx) {
    const unsigned G = gridDim.x * gridDim.y * gridDim.z;
    unsigned sum, cnt, mine, sp = 0u;
    for (;;) {
        sum = 0u; cnt = 0u; mine = 0u;
#pragma unroll
        for (unsigned j = 0; j < 16; ++j) { const unsigned c = xb_ld(&bar[XB_XCNT(j)]); sum += c; cnt += (c > 0u) ? 1u : 0u; mine = (j == x) ? c : mine; }
        if (sum == G) break;
        __builtin_amdgcn_s_sleep(1);
        if ((++sp & 255u) == 0u) { if (xb_ld(&bar[XB_TMO])) break; if (sp > XB_SPIN_CAP) { atomicAdd(&bar[XB_TMO], 1u); break; } }
    }
    nloc = mine > 0u ? mine : 1u; nx = cnt > 0u ? cnt : 1u;
}
__device__ __forceinline__ void xcd_barrier(const XcdBarrier& b) {
    asm volatile("s_waitcnt vmcnt(0)" ::: "memory");
    __syncthreads();
    if (threadIdx.x == 0) {
        unsigned* bar = b.bar;
        __builtin_amdgcn_s_waitcnt(0);
        unsigned nloc = b.st[0], nx = b.st[1];
        if (nloc == 0u) { xcd_barrier_complete(bar, b.x, nloc, nx); b.st[0] = nloc; b.st[1] = nx; }
        const unsigned old = xb_add(&bar[XB_XSUB(b.x)], 1u);
        const unsigned gen = old / nloc;
        if (old + 1u == (gen + 1u) * nloc) {
            __builtin_amdgcn_fence(__ATOMIC_RELEASE, "agent");
            asm volatile("s_waitcnt vmcnt(0)" ::: "memory");
            const unsigned og = xb_add(&bar[XB_TOP], 1u);
            const unsigned tg = og / nx;
            if (og + 1u == (tg + 1u) * nx) xb_add(&bar[XB_TOPGEN], 1u);
            else XB_SPIN(xb_ld(&bar[XB_TOPGEN]) == tg, bar);
            __builtin_amdgcn_fence(__ATOMIC_ACQUIRE, "agent");
            xb_add(&bar[XB_XGEN(b.x)], 1u);
            asm volatile("s_waitcnt vmcnt(0)" ::: "memory");
        } else {
            XB_SPIN(xb_ld(&bar[XB_XGEN(b.x)]) == gen, bar);
            __builtin_amdgcn_fence(__ATOMIC_ACQUIRE, "agent");
            asm volatile("s_waitcnt vmcnt(0)" ::: "memory");
        }
    }
    __syncthreads();
}

struct GroupOrder {
    int ng, mt, nt, G, c, mstride;
    __device__ __forceinline__ bool next(int i, pg8::Unit& u) const {
        const long L = (long)i * G + c; const int per = mt * nt; if (L >= (long)ng * per) return false;
        const int l = (int)L, g = l / per, r = l % per; u.pm = g * mstride + r / nt; u.pn = g * nt + r % nt; u.seq = i; return true;
    }
    __device__ __forceinline__ void a_ready(const pg8::Unit&) const {}
    __device__ __forceinline__ void done(const pg8::Unit&) const {}
};

struct RoundOrder {
    pg8::StaticOrder b; int r;
    __device__ __forceinline__ bool next(int i, pg8::Unit& u) const { return i == 0 && b.next(r, u); }
    __device__ __forceinline__ void a_ready(const pg8::Unit&) const {}
    __device__ __forceinline__ void done(const pg8::Unit&) const {}
};
struct PrefOrder : pg8::StaticOrder {
    const float* ssq; const float* shw; int ldsh; LAS float* slot;
    __device__ __forceinline__ void a_ready(const pg8::Unit& u) const {
        const int w = __builtin_amdgcn_readfirstlane(threadIdx.x >> 6), lane = threadIdx.x & 63;
        if (w < 2) { const int grow0 = u.pm * 256; const int jb = grow0 < MLAT ? (grow0 >> 13) : 8;
            const float* src = w == 0 ? ssq + grow0 + 4 * lane : shw + (size_t)jb * ldsh + u.pn * 256 + 4 * lane;
            LAS float* dst = slot + (u.seq & 1) * 512 + w * 256;
            __builtin_amdgcn_global_load_lds((const unsigned*)src, (LAS unsigned*)dst, 16, 0, 0); }
    }
};
__device__ __forceinline__ float logsig(float x) { return x >= 0.f ? -log1pf(expf(-x)) : x - log1pf(expf(x)); }
struct EpiWin {
    static constexpr bool PERM = true, AFTER_DRAIN = false;
    bf16* z1; bf16* a2; float* gm; unsigned char* gate; const LAS float* slot  ; const float* igb; const float* fgb;
    __device__ __forceinline__ void operator()(const f32x4 (&acc)[2][2][4][2], const pg8::Unit& u, int wr, int wc, int fr, int fq) const {
        const int pn = u.pn; const int row0 = u.pm * 256 + wr * 64 + fr;
        const LAS float* sl = slot + (u.seq & 1) * 512;
        f32x4 sw[2][2];
#pragma unroll
        for (int bj = 0; bj < 2; ++bj) { const LAS float* sp = sl + 256 + bj * 128 + wc * 32 + fq * 8; sw[bj][0] = *(const LAS f32x4*)sp; sw[bj][1] = *(const LAS f32x4*)(sp + 4); }
        float rsv[2][4];
#pragma unroll
        for (int ai = 0; ai < 2; ++ai)
#pragma unroll
            for (int m = 0; m < 4; ++m) rsv[ai][m] = sl[wr * 64 + fr + ai * 128 + m * 16];
#pragma unroll
        for (int ai = 0; ai < 2; ++ai)
#pragma unroll
            for (int m = 0; m < 4; ++m) rsv[ai][m] = rsqrtf(rsv[ai][m] * (1.0f / DM) + NORM_EPS);
        if (pn >= 9) {
#pragma unroll
            for (int ai = 0; ai < 2; ++ai)
#pragma unroll
                for (int m = 0; m < 4; ++m) rsv[ai][m] *= -1.4426950408889634f;
#pragma unroll
            for (int bj = 0; bj < 2; ++bj) { sw[bj][0] = sw[bj][0] * -1.4426950408889634f; sw[bj][1] = sw[bj][1] * -1.4426950408889634f; } }
#pragma unroll
        for (int ai = 0; ai < 2; ++ai)
#pragma unroll
            for (int m = 0; m < 4; ++m) { const int row = row0 + ai * 128 + m * 16;
                const float rs = rsv[ai][m];
#pragma unroll
                for (int bj = 0; bj < 2; ++bj) { const int cl = bj * 128 + wc * 32 + fq * 8; f32x4 v0 = acc[ai][bj][m][0] * rs + sw[bj][0], v1 = acc[ai][bj][m][1] * rs + sw[bj][1];
                    if (pn >= 9) {
                        u32x2 w; w.x = 0u; w.y = 0u;
#pragma unroll
                        for (int e = 0; e < 4; ++e) {
                            w.x = __builtin_amdgcn_cvt_pk_u8_f32(__builtin_floorf(__builtin_amdgcn_rcpf(1.0f + __builtin_amdgcn_exp2f(v0[e])) * 255.0f + 0.5f), e, w.x);
                            w.y = __builtin_amdgcn_cvt_pk_u8_f32(__builtin_floorf(__builtin_amdgcn_rcpf(1.0f + __builtin_amdgcn_exp2f(v1[e])) * 255.0f + 0.5f), e, w.y); }
                        *(u32x2*)(gate + (size_t)row * 3072 + (pn - 9) * 256 + cl) = w;
                    } else if (pn == 8) {
                        if (cl < 16) { float* d = gm + (size_t)row * 16 + cl;
                            const f32x4 bi = *(const f32x4*)(igb + (cl >> 3) * 4), bf = *(const f32x4*)(fgb + (cl >> 3) * 4); v0 = v0 + bi;
#pragma unroll
                            for (int e = 0; e < 4; ++e) v1[e] = logsig(v1[e] + bf[e]);
                            *(f32x4*)d = v0; *(f32x4*)(d + 4) = v1; }
                    } else {
                        if (pn == 5) { v0 = v0 * 0.125f; v1 = v1 * 0.125f; }
                        if (pn < 2) { v0 = v0 * 0.18033688011112042f; v1 = v1 * 0.18033688011112042f; }
                        u32x4 w; w.x = pk2(v0[0], v0[1]); w.y = pk2(v0[2], v0[3]); w.z = pk2(v1[0], v1[1]); w.w = pk2(v1[2], v1[3]);
                        if (pn == 3) { const int g = cl >> 4, cc = cl & 15; *(u32x4*)(a2 + ((size_t)g * NCH5P + (row >> 5)) * A2P + (row & 31) * 16 + cc) = w; }
                        else { const int col = (pn < 3 ? pn * 256 : 768 + (pn - 4) * 256) + cl; *(u32x4*)(z1 + (size_t)row * ZP + col) = w; }
                    }
                } }
    }
};
struct EpiS5E {
    static constexpr bool PERM = false, AFTER_DRAIN = false;
    float* E;
    __device__ __forceinline__ void operator()(const f32x4 (&acc)[2][2][4][2], const pg8::Unit& u, int wr, int wc, int fr, int fq) const {
        const int row0 = u.pm * 256 + wr * 64 + fr;
#pragma unroll
        for (int ai = 0; ai < 2; ++ai)
#pragma unroll
            for (int m = 0; m < 4; ++m) { const int row = row0 + ai * 128 + m * 16; if ((row % NCH5P) >= NCH5) continue;
#pragma unroll
                for (int bj = 0; bj < 2; ++bj)
#pragma unroll
                    for (int n = 0; n < 2; ++n) *(f32x4*)(E + (size_t)row * 256 + bj * 128 + wc * 32 + n * 16 + fq * 4) = acc[ai][bj][m][n]; }
    }
};
__device__ __forceinline__ float gelu_tanh(float x) { const float u = 0.7978845608028654f * (x + 0.044715f * x * x * x); const float e = __expf(2.0f * u); const float th = 1.0f - 2.0f / (e + 1.0f); return 0.5f * x * (1.0f + th); }
struct EpiS5Y {
    static constexpr bool PERM = true, AFTER_DRAIN = false;
    bf16* ypre;
    __device__ __forceinline__ void operator()(const f32x4 (&acc)[2][2][4][2], const pg8::Unit& u, int wr, int wc, int fr, int fq) const {
        const int g = u.pm / 9, jn = u.pn & 1; const int ch0 = (u.pm % 9) * 256 + wr * 64 + fr;
#pragma unroll
        for (int ai = 0; ai < 2; ++ai)
#pragma unroll
            for (int m = 0; m < 4; ++m) { const int ch = ch0 + ai * 128 + m * 16; if (ch >= NCH5) continue;
#pragma unroll
                for (int bj = 0; bj < 2; ++bj) { const int nl = jn * 256 + bj * 128 + wc * 32 + fq * 8; const int t = nl >> 4, c = nl & 15; const f32x4 v0 = acc[ai][bj][m][0], v1 = acc[ai][bj][m][1];
                    u32x4 w; w.x = pk2(gelu_tanh(v0[0]), gelu_tanh(v0[1])); w.y = pk2(gelu_tanh(v0[2]), gelu_tanh(v0[3])); w.z = pk2(gelu_tanh(v1[0]), gelu_tanh(v1[1])); w.w = pk2(gelu_tanh(v1[2]), gelu_tanh(v1[3]));
                    *(u32x4*)(ypre + ((size_t)ch * 32 + t) * 256 + g * 16 + c) = w; } asm volatile("" ::: "memory"); }
    }
};
struct EpiGlu {
    static constexpr bool PERM = true, AFTER_DRAIN = false;
    const bf16* ypre; bf16* ys; const float* bias; int ldy;
    __device__ __forceinline__ void operator()(const f32x4 (&acc)[2][2][4][2], const pg8::Unit& u, int wr, int wc, int fr, int fq) const {
        const int row0 = u.pm * 256 + wr * 64 + fr; const int colb = wc * 32 + fq * 8;
        f32x4 bs[2][2];
#pragma unroll
        for (int bj = 0; bj < 2; ++bj) { bs[bj][0] = *(const f32x4*)(bias + bj * 128 + colb); bs[bj][1] = *(const f32x4*)(bias + bj * 128 + colb + 4); }
#pragma unroll
        for (int ai = 0; ai < 2; ++ai) {
            u32x4 yv[4][2];
#pragma unroll
            for (int m = 0; m < 4; ++m)
#pragma unroll
                for (int bj = 0; bj < 2; ++bj) yv[m][bj] = *(const u32x4*)(ypre + (size_t)(row0 + ai * 128 + m * 16) * 256 + bj * 128 + colb);
#pragma unroll
            for (int m = 0; m < 4; ++m)
#pragma unroll
                for (int bj = 0; bj < 2; ++bj) { const f32x4 v0 = acc[ai][bj][m][0] + bs[bj][0], v1 = acc[ai][bj][m][1] + bs[bj][1]; const u32x4 y = yv[m][bj];
                    u32x4 w;
                    w.x = pk2(bflo(y.x) * sigmoidf_(v0[0]), bfhi(y.x) * sigmoidf_(v0[1])); w.y = pk2(bflo(y.y) * sigmoidf_(v0[2]), bfhi(y.y) * sigmoidf_(v0[3]));
                    w.z = pk2(bflo(y.z) * sigmoidf_(v1[0]), bfhi(y.z) * sigmoidf_(v1[1])); w.w = pk2(bflo(y.w) * sigmoidf_(v1[2]), bfhi(y.w) * sigmoidf_(v1[3]));
                    *(u32x4*)(ys + (size_t)(row0 + ai * 128 + m * 16) * ldy + bj * 128 + colb) = w; }
            asm volatile("" ::: "memory");
        }
    }
};
struct EpiMergeF {
    static constexpr bool PERM = true, AFTER_DRAIN = false;
    struct State { f32x4 Y[2][4][2]; u32x2 gq[2][4]; };
    bf16* y; const unsigned char* gate;
    __device__ __forceinline__ void fetch(State& st, const pg8::Unit& u, int wr, int wc, int fr, int fq, int goff) const {
        const unsigned char* gp = gate + (size_t)(u.pm * 256 + wr * 64 + fr) * 3072 + goff + u.pn * 128 + wc * 32 + fq * 8;
#pragma unroll
        for (int ai = 0; ai < 2; ++ai)
#pragma unroll
            for (int m = 0; m < 4; ++m) st.gq[ai][m] = *(const u32x2*)(gp + (size_t)(ai * 128 + m * 16) * 3072);
    }
    __device__ __forceinline__ void close(f32x4 (&acc)[2][2][4][2], State& st) const {
        const float s = 1.0f / 255.0f;
#pragma unroll
        for (int ai = 0; ai < 2; ++ai)
#pragma unroll
            for (int m = 0; m < 4; ++m) { const u32x2 g = st.gq[ai][m];
                const f32x4 g0 = {(float)(g.x & 255u) * s, (float)((g.x >> 8) & 255u) * s, (float)((g.x >> 16) & 255u) * s, (float)(g.x >> 24) * s};
                const f32x4 g1 = {(float)(g.y & 255u) * s, (float)((g.y >> 8) & 255u) * s, (float)((g.y >> 16) & 255u) * s, (float)(g.y >> 24) * s};
                st.Y[ai][m][0] += g0 * acc[ai][0][m][0]; st.Y[ai][m][1] += g1 * acc[ai][0][m][1];
                acc[ai][0][m][0] = (f32x4){0.f, 0.f, 0.f, 0.f}; acc[ai][0][m][1] = (f32x4){0.f, 0.f, 0.f, 0.f}; }
    }
    static constexpr int NSEG = 3;
    __device__ __forceinline__ int seg_end(int seg) const { return seg == 0 ? 8 : (seg == 1 ? 12 : 16); }
    __device__ __forceinline__ void init(State& st) const {
#pragma unroll
        for (int ai = 0; ai < 2; ++ai)
#pragma unroll
            for (int m = 0; m < 4; ++m) { st.Y[ai][m][0] = (f32x4){0.f, 0.f, 0.f, 0.f}; st.Y[ai][m][1] = (f32x4){0.f, 0.f, 0.f, 0.f}; st.gq[ai][m] = (u32x2){0u, 0u}; }
    }
    __device__ __forceinline__ void seg_open(int seg, State& st, const pg8::Unit& u, int wr, int wc, int fr, int fq) const { fetch(st, u, wr, wc, fr, fq, seg * 1024); }
    __device__ __forceinline__ void seg_close(int seg, f32x4 (&acc)[2][2][4][2], State& st) const { close(acc, st); }
    __device__ __forceinline__ void finish(f32x4 (&acc)[2][2][4][2], State& st, const pg8::Unit& u, int wr, int wc, int fr, int fq) const {
        bf16* yp = y + (size_t)(u.pm * 256 + wr * 64 + fr) * 1024 + u.pn * 128 + wc * 32 + fq * 8;
#pragma unroll
        for (int ai = 0; ai < 2; ++ai)
#pragma unroll
            for (int m = 0; m < 4; ++m) { const f32x4 a = st.Y[ai][m][0], b = st.Y[ai][m][1]; u32x4 w; w.x = pk2(a[0], a[1]); w.y = pk2(a[2], a[3]); w.z = pk2(b[0], b[1]); w.w = pk2(b[2], b[3]);
                *(u32x4*)(yp + (size_t)(ai * 128 + m * 16) * 1024) = w; }
    }
};
template <bool FIRST> struct EpiMerge {
    static constexpr bool PERM = true, AFTER_DRAIN = false;
    bf16* y; const unsigned char* gate; int goff;
    __device__ __forceinline__ void operator()(const f32x4 (&acc)[2][2][4][2], const pg8::Unit& u, int wr, int wc, int fr, int fq) const {
        const int row0 = u.pm * 256 + wr * 64 + fr; const int col0 = u.pn * 256 + wc * 32 + fq * 8; const float s = 1.0f / 255.0f;
#pragma unroll
        for (int ai = 0; ai < 2; ++ai) {
            u32x2 gq[4][2]; u32x4 old[4][2];
#pragma unroll
            for (int m = 0; m < 4; ++m)
#pragma unroll
                for (int bj = 0; bj < 2; ++bj) { const size_t row = (size_t)(row0 + ai * 128 + m * 16); gq[m][bj] = *(const u32x2*)(gate + row * 3072 + goff + col0 + bj * 128);
                    if (!FIRST) old[m][bj] = *(const u32x4*)(y + row * 1024 + col0 + bj * 128); }
#pragma unroll
            for (int m = 0; m < 4; ++m)
#pragma unroll
                for (int bj = 0; bj < 2; ++bj) { const f32x4 v0 = acc[ai][bj][m][0], v1 = acc[ai][bj][m][1]; const u32x2 g = gq[m][bj];
                    float o[8];
                    o[0] = v0[0] * ((float)(g.x & 255u) * s); o[1] = v0[1] * ((float)((g.x >> 8) & 255u) * s); o[2] = v0[2] * ((float)((g.x >> 16) & 255u) * s); o[3] = v0[3] * ((float)(g.x >> 24) * s);
                    o[4] = v1[0] * ((float)(g.y & 255u) * s); o[5] = v1[1] * ((float)((g.y >> 8) & 255u) * s); o[6] = v1[2] * ((float)((g.y >> 16) & 255u) * s); o[7] = v1[3] * ((float)(g.y >> 24) * s);
                    if (!FIRST) { const u32x4 od = old[m][bj]; o[0] += bflo(od.x); o[1] += bfhi(od.x); o[2] += bflo(od.y); o[3] += bfhi(od.y); o[4] += bflo(od.z); o[5] += bfhi(od.z); o[6] += bflo(od.w); o[7] += bfhi(od.w); }
                    u32x4 w; w.x = pk2(o[0], o[1]); w.y = pk2(o[2], o[3]); w.z = pk2(o[4], o[5]); w.w = pk2(o[6], o[7]);
                    *(u32x4*)(y + (size_t)(row0 + ai * 128 + m * 16) * 1024 + col0 + bj * 128) = w; }
            asm volatile("" ::: "memory");
        }
    }
};
template <bool EMIT, bool NH = false> struct EpiResid {
    static constexpr int NBJ = NH ? 1 : 2;
    static constexpr bool PERM = true, AFTER_DRAIN = false;
    const float* xin_lat; const float* xin_ctx; float* xout_lat; float* xout_ctx; const float* gvec  ; int rowbase;
    bf16* hn; const float* gam  ; float* ssq;
    __device__ __forceinline__ void operator()(const f32x4 (&acc)[2][2][4][2], const pg8::Unit& u, int wr, int wc, int fr, int fq) const {
        const int grow0 = rowbase + u.pm * 256; const bool isc = grow0 >= MLAT; const int j = isc ? 8 : (grow0 >> 13);
        const float* xi = isc ? xin_ctx - (size_t)MLAT * DM : xin_lat; float* xo = isc ? xout_ctx - (size_t)MLAT * DM : xout_lat;
        const int row0 = grow0 + wr * 64 + fr; const int colb = u.pn * (NH ? 128 : 256) + wc * 32 + fq * 8;
        f32x4 gg[2][2], gm_[2][2];
#pragma unroll
        for (int bj = 0; bj < NBJ; ++bj) { const float* gp = gvec + (size_t)j * 6144 + colb + bj * 128; gg[bj][0] = *(const f32x4*)gp; gg[bj][1] = *(const f32x4*)(gp + 4);
            if (EMIT) { const float* mp = gam + (size_t)j * 1024 + colb + bj * 128; gm_[bj][0] = *(const f32x4*)mp; gm_[bj][1] = *(const f32x4*)(mp + 4); } }
        f32x4 xv[3][2][2];
        auto loadx = [&](int k, f32x4 (&d)[2][2]) {
#pragma unroll
            for (int bj = 0; bj < NBJ; ++bj) { const float* p = xi + (size_t)(row0 + (k >> 2) * 128 + (k & 3) * 16) * DM + colb + bj * 128; d[bj][0] = *(const f32x4*)p; d[bj][1] = *(const f32x4*)(p + 4); } };
        loadx(0, xv[0]); loadx(1, xv[1]);
#pragma unroll
        for (int k = 0; k < 8; ++k) { const int ai = k >> 2, m = k & 3;
            if (k + 2 < 8) loadx(k + 2, xv[(k + 2) % 3]);
            __builtin_amdgcn_sched_barrier(0);
            const size_t row = (size_t)(row0 + ai * 128 + m * 16); float sq = 0.f;
#pragma unroll
            for (int bj = 0; bj < NBJ; ++bj) { const f32x4 x0 = xv[k % 3][bj][0] + gg[bj][0] * acc[ai][bj][m][0], x1 = xv[k % 3][bj][1] + gg[bj][1] * acc[ai][bj][m][1];
                float* op = xo + row * DM + colb + bj * 128; *(f32x4*)op = x0; *(f32x4*)(op + 4) = x1;
                if (EMIT) { sq += ((x0[0] * x0[0] + x0[1] * x0[1]) + (x0[2] * x0[2] + x0[3] * x0[3])) + ((x1[0] * x1[0] + x1[1] * x1[1]) + (x1[2] * x1[2] + x1[3] * x1[3]));
                    const f32x4 h0 = x0 * gm_[bj][0], h1 = x1 * gm_[bj][1]; u32x4 w; w.x = pk2(h0[0], h0[1]); w.y = pk2(h0[2], h0[3]); w.z = pk2(h1[0], h1[1]); w.w = pk2(h1[2], h1[3]);
                    *(u32x4*)(hn + row * DM + colb + bj * 128) = w; } }
            if (EMIT) { sq += __shfl_xor(sq, 16); sq += __shfl_xor(sq, 32); if (fq == 0) atomicAdd(ssq + row, sq); }
            __builtin_amdgcn_sched_barrier(0);
        }
    }
};
__device__ __forceinline__ float dpp_prev(float self, float up) {
    const int seam = __builtin_amdgcn_mov_dpp(__builtin_bit_cast(int, up), 0x121  , 0xf, 0xf, false);
    return __builtin_bit_cast(float, __builtin_amdgcn_update_dpp(seam, __builtin_bit_cast(int, self), 0x111  , 0xf, 0xf, false)); }
__device__ __forceinline__ float dpp_next(float self, float dn) {
    const int seam = __builtin_amdgcn_mov_dpp(__builtin_bit_cast(int, dn), 0x12F  , 0xf, 0xf, false);
    return __builtin_bit_cast(float, __builtin_amdgcn_update_dpp(seam, __builtin_bit_cast(int, self), 0x101  , 0xf, 0xf, false)); }
struct EpiUpConv {
    static constexpr bool PERM = true, AFTER_DRAIN = false;
    bf16* act; float* raw; const LAS float* slot  ; const float* cw  ; const float* cb  ; LAS float* X  ;
    __device__ __forceinline__ void operator()(f32x4 (&acc)[2][2][4][2], const pg8::Unit& u, int wr, int wc, int fr_, int fq_) const {
        int fr = fr_, fq = fq_; asm volatile("" : "+v"(fr), "+v"(fq));
        const int grow0 = u.pm * 256; const int row0 = grow0 + wr * 64 + fr; const int cl = wc * 32 + fq * 8;
        { f32x4 sw[2][2]; float rsv[2][4]; const LAS float* sl = slot + (u.seq & 1) * 512;
#pragma unroll
          for (int bj = 0; bj < 2; ++bj) { const LAS float* sp = sl + 256 + bj * 128 + cl; sw[bj][0] = *(const LAS f32x4*)sp; sw[bj][1] = *(const LAS f32x4*)(sp + 4); }
#pragma unroll
          for (int ai = 0; ai < 2; ++ai)
#pragma unroll
              for (int m = 0; m < 4; ++m) rsv[ai][m] = sl[wr * 64 + fr + ai * 128 + m * 16];
#pragma unroll
          for (int ai = 0; ai < 2; ++ai)
#pragma unroll
              for (int m = 0; m < 4; ++m) { const float rs = rsqrtf(rsv[ai][m] * (1.0f / DM) + NORM_EPS);
#pragma unroll
                  for (int bj = 0; bj < 2; ++bj)
#pragma unroll
                      for (int n = 0; n < 2; ++n) { acc[ai][bj][m][n] = acc[ai][bj][m][n] * rs + sw[bj][n]; asm volatile("" : "+v"(acc[ai][bj][m][n])); } } }
#pragma unroll
        for (int ai = 0; ai < 2; ++ai) { const int bidx = 2 * ai + wr;
            if (fr == 0) {
#pragma unroll
                for (int bj = 0; bj < 2; ++bj) { LAS float* xp = X + (2 * bidx) * 256 + bj * 128 + cl; *(LAS f32x4*)xp = acc[ai][bj][0][0]; *(LAS f32x4*)(xp + 4) = acc[ai][bj][0][1]; } }
            if (fr == 15) {
#pragma unroll
                for (int bj = 0; bj < 2; ++bj) { LAS float* xp = X + (2 * bidx + 1) * 256 + bj * 128 + cl; *(LAS f32x4*)xp = acc[ai][bj][3][0]; *(LAS f32x4*)(xp + 4) = acc[ai][bj][3][1]; } }
        }
        if (wr == 0 && fr < 2) {
#pragma unroll
            for (int bj = 0; bj < 2; ++bj) { float* rp = raw + ((size_t)u.pm * 4 + fr) * NUP + u.pn * 256 + bj * 128 + cl; *(f32x4*)rp = acc[0][bj][0][0]; *(f32x4*)(rp + 4) = acc[0][bj][0][1]; } }
        if (wr == 1 && fr >= 14) {
#pragma unroll
            for (int bj = 0; bj < 2; ++bj) { float* rp = raw + ((size_t)u.pm * 4 + fr - 12) * NUP + u.pn * 256 + bj * 128 + cl; *(f32x4*)rp = acc[1][bj][3][0]; *(f32x4*)(rp + 4) = acc[1][bj][3][1]; } }
        asm volatile("s_waitcnt lgkmcnt(0)" ::: "memory"); __builtin_amdgcn_s_barrier(); asm volatile("" ::: "memory"); __builtin_amdgcn_sched_barrier(0);
        const int ch = u.pn * 128 + cl;
#pragma unroll
        for (int ai = 0; ai < 2; ++ai) { const int bidx = 2 * ai + wr;
            u32x2 wlo[4];
#pragma unroll
            for (int n = 0; n < 2; ++n) {
                f32x4 ca[4];
#pragma unroll
                for (int bj = 0; bj < 2; ++bj) {
                    const float* wp = cw + bj * DFF + ch + 4 * n;
                    const f32x4 w0 = *(const f32x4*)wp, w1 = *(const f32x4*)(wp + NUP), w2 = *(const f32x4*)(wp + 2 * NUP), bb = *(const f32x4*)(cb + bj * DFF + ch + 4 * n);
                    const f32x4 xp = bidx > 0 ? *(const LAS f32x4*)(X + (2 * bidx - 1) * 256 + bj * 128 + cl + 4 * n) : (f32x4){0.f, 0.f, 0.f, 0.f};
                    const f32x4 xn = bidx < 3 ? *(const LAS f32x4*)(X + (2 * bidx + 2) * 256 + bj * 128 + cl + 4 * n) : (f32x4){0.f, 0.f, 0.f, 0.f};
#pragma unroll
                    for (int m = 0; m < 4; ++m) { const f32x4 self = acc[ai][bj][m][n]; const f32x4 us = m == 0 ? xp : acc[ai][bj][m == 0 ? 0 : m - 1][n]; const f32x4 ds = m == 3 ? xn : acc[ai][bj][m == 3 ? 3 : m + 1][n]; f32x4 o;
#pragma unroll
                        for (int e = 0; e < 4; ++e) { const float pv = dpp_prev(self[e], us[e]); const float nx = dpp_next(self[e], ds[e]); o[e] = bb[e] + w0[e] * pv + w1[e] * self[e] + w2[e] * nx; }
                        asm volatile("" : "+v"(o));
                        if (bj == 0) ca[m] = o;
                        else { const bool skip = (bidx == 0 && m == 0 && fr == 0) || (bidx == 3 && m == 3 && fr == 15);
                            u32x2 w; w.x = pk2(ca[m][0] * sigmoidf_(ca[m][0]) * o[0], ca[m][1] * sigmoidf_(ca[m][1]) * o[1]); w.y = pk2(ca[m][2] * sigmoidf_(ca[m][2]) * o[2], ca[m][3] * sigmoidf_(ca[m][3]) * o[3]);
                            if (n == 0) wlo[m] = w;
                            else if (!skip) { u32x4 w4; w4.x = wlo[m].x; w4.y = wlo[m].y; w4.z = w.x; w4.w = w.y; *(u32x4*)(act + (size_t)(row0 + ai * 128 + m * 16) * DFF + ch) = w4; } }
                        __builtin_amdgcn_sched_barrier(0); }
                    asm volatile("" ::: "memory");
                }
            }
        }
    }
};
struct EpiPlain {
    static constexpr bool PERM = true, AFTER_DRAIN = false;
    bf16* O; int ldc;
    __device__ __forceinline__ void operator()(const f32x4 (&acc)[2][2][4][2], const pg8::Unit& u, int wr, int wc, int fr, int fq) const {
        const int row0 = u.pm * 256 + wr * 64 + fr;
#pragma unroll
        for (int ai = 0; ai < 2; ++ai)
#pragma unroll
            for (int m = 0; m < 4; ++m) { bf16* rp = O + (size_t)(row0 + ai * 128 + m * 16) * ldc + u.pn * 256 + wc * 32 + fq * 8;
#pragma unroll
                for (int bj = 0; bj < 2; ++bj) { const f32x4 v0 = acc[ai][bj][m][0], v1 = acc[ai][bj][m][1]; u32x4 w; w.x = pk2(v0[0], v0[1]); w.y = pk2(v0[2], v0[3]); w.z = pk2(v1[0], v1[1]); w.w = pk2(v1[2], v1[3]); *(u32x4*)(rp + bj * 128) = w; } }
    }
};

struct Args { const float* in[32]; float* out; unsigned char* ws; int ph_lo, ph_hi; };

typedef const __attribute__((address_space(4))) Args* KArgP;
__device__ __forceinline__ KArgP kargs() { KArgP p = (KArgP)__builtin_amdgcn_kernarg_segment_ptr(); asm volatile("" : "+s"(p)); return p; }
constexpr int GRID = 256;
struct Ctx {
    LAS unsigned char* lds; int tid, lane, wave, G, bid;
    KArgP ap;
};
__device__ __forceinline__ bool phase_enter(Ctx& C) { C.ap = kargs(); asm volatile("" : "+v"(C.tid), "+v"(C.lane)); return true; }
#define WSP(T, off) ((T*)(C.ap->ws + (off)))
#define INP(i) (C.ap->in[i])
#define OUTP (C.ap->out)

__device__ __forceinline__ void sincos_d(double th, double& s, double& c) {
    const double TWO_PI = 6.283185307179586476925287;
    const double n = rint(th / TWO_PI); const double r = (th - n * 6.28318530717958623200) - n * 2.4492935982947064e-16;
    const double x = r * 0.25, x2 = x * x;
    double ss = x * (1.0 - x2 / 6.0 * (1.0 - x2 / 20.0 * (1.0 - x2 / 42.0 * (1.0 - x2 / 72.0 * (1.0 - x2 / 110.0 * (1.0 - x2 / 156.0 * (1.0 - x2 / 210.0)))))));
    double cc = 1.0 - x2 / 2.0 * (1.0 - x2 / 12.0 * (1.0 - x2 / 30.0 * (1.0 - x2 / 56.0 * (1.0 - x2 / 90.0 * (1.0 - x2 / 132.0 * (1.0 - x2 / 182.0 * (1.0 - x2 / 240.0)))))));
    double s2 = 2.0 * ss * cc, c2 = 1.0 - 2.0 * ss * ss;
    s = 2.0 * s2 * c2; c = 1.0 - 2.0 * s2 * s2;
}

template <int MODE> __device__ __forceinline__ void cvt_T(const Ctx& C, const float* src, int K, int Nsrc, bf16* dst, int Ndst, int ldd = 0, int koff = 0) {
    if (ldd == 0) ldd = K;
    LAS float* scr = (LAS float*)(C.lds + C.wave * 8448);
    const int nblk = Ndst / 32, nitems = (K / 64) * nblk; const int lane = C.lane;
    for (int it = C.bid * 8 + C.wave; it < nitems; it += C.G * 8) {
        const int kb = it / nblk, nb = it % nblk, k0 = 64 * kb, n0 = 32 * nb; const int n = n0 + (lane & 31);
        int sn = n; if (MODE == 1) sn = (n < 2064) ? n : (n < 2304 ? -1 : n - 240);
        if (MODE == 2) sn = ((n >> 7) & 1) * DFF + (n >> 8) * 128 + (n & 127);
        float v[32];
#pragma unroll
        for (int i = 0; i < 32; ++i) v[i] = sn >= 0 ? src[(size_t)(k0 + 2 * i + (lane >> 5)) * Nsrc + sn] : 0.f;
#pragma unroll
        for (int i = 0; i < 32; ++i) scr[(2 * i + (lane >> 5)) * 33 + (lane & 31)] = v[i];
        asm volatile("s_waitcnt lgkmcnt(0)" ::: "memory");
        const int c = lane & 7;
#pragma unroll
        for (int j = 0; j < 4; ++j) { const int nn = (lane >> 3) + 8 * j; const LAS float* sp = scr + (8 * c) * 33 + nn;
            u32x4 o; o.x = pk2(sp[0 * 33], sp[1 * 33]); o.y = pk2(sp[2 * 33], sp[3 * 33]); o.z = pk2(sp[4 * 33], sp[5 * 33]); o.w = pk2(sp[6 * 33], sp[7 * 33]);
            *(u32x4*)(dst + (size_t)(n0 + nn) * ldd + koff + k0 + 8 * c) = o; }
        asm volatile("s_waitcnt lgkmcnt(0)" ::: "memory");
    }
}

__device__ __forceinline__ void pro0(const Ctx& C) {
    for (int l = 0; l < 2; ++l) {
        cvt_T<1>(C, INP(8) + (size_t)l * 1024 * 5136, 1024, 5136, WSP(bf16, WS_WIN) + (size_t)l * NIN * 1024, NIN);
        cvt_T<0>(C, INP(23) + (size_t)l * 512 * 1024, 512, 1024, WSP(bf16, WS_WBA) + (size_t)l * 1024 * 1024, 1024, 1024, 0);
        cvt_T<0>(C, INP(24) + (size_t)l * 256 * 1024, 256, 1024, WSP(bf16, WS_WBA) + (size_t)l * 1024 * 1024, 1024, 1024, 512);
        cvt_T<0>(C, INP(25) + (size_t)l * 256 * 1024, 256, 1024, WSP(bf16, WS_WBA) + (size_t)l * 1024 * 1024, 1024, 1024, 768);
        cvt_T<0>(C, INP(26) + (size_t)l * 1024 * 1024, 1024, 1024, WSP(bf16, WS_WOUT) + (size_t)l * 1024 * 1024, 1024);
        cvt_T<2>(C, INP(27) + (size_t)l * 1024 * NUP, 1024, NUP, WSP(bf16, WS_WUP) + (size_t)l * NUP * 1024, NUP);
        cvt_T<0>(C, INP(30) + (size_t)l * DFF * 1024, DFF, 1024, WSP(bf16, WS_WDN) + (size_t)l * 1024 * DFF, 1024);
        cvt_T<0>(C, INP(18) + (size_t)l * 256 * 256, 256, 256, WSP(bf16, WS_WGLU) + (size_t)l * 256 * 256, 256);
    }
    __syncthreads();
    {
        LAS float* sl = (LAS float*)C.lds;
        float* modp = WSP(float, WS_MODP);
        for (int it = C.bid; it < 384; it += C.G) {
            const int l = it / 192, r = it % 192, ks = r / 12, nb = r % 12, n = nb * 512 + C.tid;
            __syncthreads();
            for (int e = C.tid; e < 576; e += 512) { const int j = e >> 6, k = ks * 64 + (e & 63); const float cv = (j < 8) ? INP(1)[j * 1024 + k] : INP(3)[k]; sl[e] = cv / (1.0f + expf(-cv)); }
            __syncthreads();
            float a[9];
#pragma unroll
            for (int j = 0; j < 9; ++j) a[j] = 0.f;
            const float* w = INP(4) + ((size_t)l * 1024 + ks * 64) * 6144 + n;
#pragma unroll 16
            for (int k = 0; k < 64; ++k) { const float wv = w[(size_t)k * 6144];
#pragma unroll
                for (int j = 0; j < 9; ++j) a[j] += sl[j * 64 + k] * wv; }
#pragma unroll
            for (int j = 0; j < 9; ++j) modp[((size_t)(l * 16 + ks) * 9 + j) * 6144 + n] = a[j];
        }
        __syncthreads();
    }
    { float* q = WSP(float, WS_SSQ) + MTOT; for (long i = (long)C.bid * 512 + C.tid; i < (long)3 * MTOT; i += (long)C.G * 512) q[i] = 0.f; }
    const int gt = (GRID - 1 - C.bid) * 512 + C.tid;
    if (gt < 4096) {
        const int p = gt & 63, g = (gt >> 6) & 15, d = (gt >> 10) & 1, l = gt >> 11;
        const size_t pi = (((size_t)l * 2 + d) * 16 + g) * 64 + p;
        const double are = (double)INP(10)[pi], aim = (double)INP(11)[pi];
        const double dt = exp((double)INP(12)[(l * 2 + d) * 16 + g]);
        const double dre = dt * are, dim = dt * aim;
        float* lp = WSP(float, WS_LP) + pi * 66;
        double l1r = 0, l1i = 0;
        for (int k = 0; k <= 32; ++k) { double s, c; sincos_d((double)k * dim, s, c); const double mg = exp((double)k * dre); lp[2 * k] = (float)(mg * c); lp[2 * k + 1] = (float)(mg * s); if (k == 1) { l1r = mg * c; l1i = mg * s; } }
        const double den = are * are + aim * aim;
        const double cr = ((l1r - 1.0) * are + l1i * aim) / den, ci = (l1i * are - (l1r - 1.0) * aim) / den;
        float* bb = WSP(float, WS_BB) + pi * 32;
        const size_t bi = (((size_t)l * 16 + g) * 64 + p) * 16;
        for (int c = 0; c < 16; ++c) { const double br = (double)INP(13)[bi + c], bim = (double)INP(14)[bi + c]; bb[2 * c] = (float)(cr * br - ci * bim); bb[2 * c + 1] = (float)(cr * bim + ci * br); }
    }
    if (gt >= 4096 && gt < 4096 + 2048) {
        const int e = gt - 4096, pos = e >> 4, i = e & 15;
        const double inv = exp(-(double)i / 16.0 * 9.210340371976184);
        double s, c; sincos_d((double)pos * inv, s, c);
        float* rt = WSP(float, WS_ROPE) + e * 2; rt[0] = (float)c; rt[1] = (float)s;
    }
}
__device__ __forceinline__ void pro1(const Ctx& C) {
    const long gt = (long)C.bid * 512 + C.tid, NT = (long)C.G * 512;
    { const float* modp = WSP(float, WS_MODP); float* modv = WSP(float, WS_MODV);
      for (long i = gt; i < 2 * 9 * 6144; i += NT) { const int n = (int)(i % 6144), j = (int)((i / 6144) % 9), l = (int)(i / (9 * 6144)); float s = INP(5)[l * 6144 + n];
          for (int ks = 0; ks < 16; ++ks) s += modp[((size_t)(l * 16 + ks) * 9 + j) * 6144 + n];
          modv[i] = s; } }
    { const float* LP = WSP(float, WS_LP); const float* BB = WSP(float, WS_BB); float* KD = WSP(float, WS_KD);
      for (long i = gt; i < 2L * 16 * 2 * 32 * 16; i += NT) {
          const int cp = (int)(i & 15), k = (int)((i >> 4) & 31); const int lgd = __builtin_amdgcn_readfirstlane((int)(i >> 9)); const int d = lgd & 1, lg = lgd >> 1;
          const float* cre = INP(15) + (size_t)lg * 16 * 64; const float* cim = INP(16) + (size_t)lg * 16 * 64;
          const size_t pb = ((size_t)(lg >> 4) * 2 + d) * 16 * 64 + (size_t)(lg & 15) * 64;
          float acc[16];
#pragma unroll
          for (int c = 0; c < 16; ++c) acc[c] = 0.f;
          for (int p0 = 0; p0 < 64; p0 += 4) {
#pragma unroll
              for (int pp = 0; pp < 4; ++pp) { const int p = p0 + pp;
                  const float lr = LP[(pb + p) * 66 + 2 * k], li = LP[(pb + p) * 66 + 2 * k + 1]; const float br = BB[(pb + p) * 32 + 2 * cp], bi = BB[(pb + p) * 32 + 2 * cp + 1];
                  const float zr = lr * br - li * bi, zi = lr * bi + li * br;
#pragma unroll
                  for (int c = 0; c < 16; ++c) acc[c] += cre[c * 64 + p] * zr - cim[c * 64 + p] * zi; } }
#pragma unroll
          for (int c = 0; c < 16; ++c) KD[((size_t)lgd * 32 + k) * 256 + c * 16 + cp] = acc[c]; } }
    { const float* LP = WSP(float, WS_LP); const float* BB = WSP(float, WS_BB);
      bf16* W1 = WSP(bf16, WS_W1);
      for (long i = gt; i < 2L * 16 * 256 * 64; i += NT) {
          const int kc = (int)(i & 63), n = (int)((i >> 6) & 255), g = (int)((i >> 14) & 15), l = (int)(i >> 18);
          const int tau = kc >> 1, c0 = (kc & 1) * 8, p = n & 63, part = (n >> 6) & 1, d = n >> 7;
          const size_t pi = (((size_t)l * 2 + d) * 16 + g) * 64 + p; const int e = d == 0 ? 31 - tau : tau;
          const float lr = LP[pi * 66 + 2 * e], li = LP[pi * 66 + 2 * e + 1]; float v[8];
#pragma unroll
          for (int j = 0; j < 8; ++j) { const float br = BB[pi * 32 + 2 * (c0 + j)], bi = BB[pi * 32 + 2 * (c0 + j) + 1]; v[j] = part == 0 ? (lr * br - li * bi) : (lr * bi + li * br); }
          u32x4 w; w.x = pk2(v[0], v[1]); w.y = pk2(v[2], v[3]); w.z = pk2(v[4], v[5]); w.w = pk2(v[6], v[7]);
          *(u32x4*)(W1 + (((size_t)l * 16 + g) * 256 + n) * 512 + kc * 8) = w; } }
}
__device__ __forceinline__ void pro2(const Ctx& C) {
    const long gt = (long)C.bid * 512 + C.tid, NT = (long)C.G * 512;
    { const float* modv = WSP(float, WS_MODV); float* gam = WSP(float, WS_GAM);
      for (long i = gt; i < 2 * 2 * 9 * 1024; i += NT) { const int k = (int)(i & 1023), j = (int)((i >> 10) % 9), w = (int)((i / 9216) & 1), l = (int)(i / 18432);
          gam[i] = (w == 0 ? INP(6) : INP(7))[l * 1024 + k] * (1.0f + modv[((size_t)l * 9 + j) * 6144 + (w == 0 ? 1024 : 4096) + k]); } }
    { const float* modv = WSP(float, WS_MODV); LAS float* red = (LAS float*)C.lds;
      const int nbi = NIN / 128, nbu = NUP / 128, per = nbi + nbu;
      for (int it = C.bid; it < 2 * per; it += C.G) {
          const int l = it / per, r = it % per; const bool isu = r >= nbi; const int n = (isu ? r - nbi : r) * 128 + 2 * C.lane;
          int sn = n; if (!isu) sn = (n < 2064) ? n : (n < 2304 ? -1 : n - 240); else sn = ((n >> 7) & 1) * DFF + (n >> 8) * 128 + (n & 127);
          const float* W = isu ? INP(27) + (size_t)l * 1024 * NUP : INP(8) + (size_t)l * 1024 * 5136; const int ldw = isu ? NUP : 5136;
          const float* sh = modv + (size_t)l * 9 * 6144 + (isu ? 3072 : 0);
          float a0[9], a1[9];
#pragma unroll
          for (int j = 0; j < 9; ++j) { a0[j] = 0.f; a1[j] = 0.f; }
          const int kb = C.wave * 128;
#pragma unroll 8
          for (int k = kb; k < kb + 128; ++k) { f32x2_t wv = {0.f, 0.f}; if (sn >= 0) wv = *(const f32x2_t*)(W + (size_t)k * ldw + sn);
#pragma unroll
              for (int j = 0; j < 9; ++j) { const float sv = sh[(size_t)j * 6144 + k]; a0[j] += sv * wv.x; a1[j] += sv * wv.y; } }
          __syncthreads();
#pragma unroll
          for (int j = 0; j < 9; ++j) { f32x2_t o = {a0[j], a1[j]}; *(LAS f32x2_t*)(red + (C.wave * 9 + j) * 128 + 2 * C.lane) = o; }
          __syncthreads();
          for (int e = C.tid; e < 1152; e += 512) { float t = 0.f;
#pragma unroll
              for (int w = 0; w < 8; ++w) t += red[w * 1152 + e];
              const int j = e >> 7, nn = (isu ? r - nbi : r) * 128 + (e & 127);
              if (isu) WSP(float, WS_SHWU)[((size_t)l * 9 + j) * NUP + nn] = t; else WSP(float, WS_SHWI)[((size_t)l * 9 + j) * NIN + nn] = t; }
      }
      __syncthreads(); }
    const float* LP = WSP(float, WS_LP); const float* BB = WSP(float, WS_BB); const float* KD = WSP(float, WS_KD);
    { bf16* W2 = WSP(bf16, WS_W2);
      for (long i = gt; i < 2L * 16 * 512 * 96; i += NT) {
          const int kc = (int)(i % 96); const long r = i / 96; const int n = (int)(r & 511), g = (int)((r >> 9) & 15), l = (int)(r >> 13);
          const int t = n >> 4, c = n & 15; float v[8];
          if (kc < 64) { const int tau = kc >> 1, c0 = (kc & 1) * 8;
              const float* kf = KD + ((((size_t)l * 16 + g) * 2 + 0) * 32) * 256; const float* kb = KD + ((((size_t)l * 16 + g) * 2 + 1) * 32) * 256;
#pragma unroll
              for (int j = 0; j < 8; ++j) { const int cp = c0 + j; float s = 0.f;
                  if (tau <= t) s += kf[(t - tau) * 256 + c * 16 + cp];
                  if (tau >= t) s += kb[(tau - t) * 256 + c * 16 + cp];
                  if (tau == t && cp == c) s += INP(17)[l * 256 + g * 16 + c];
                  v[j] = s; }
          } else { const int kk = (kc - 64) * 8; const int d = kk >> 7, part = (kk >> 6) & 1, p0 = kk & 63; const int e = d == 0 ? t + 1 : 32 - t;
              const float* cre = INP(15) + (((size_t)l * 16 + g) * 16 + c) * 64; const float* cim = INP(16) + (((size_t)l * 16 + g) * 16 + c) * 64;
#pragma unroll
              for (int j = 0; j < 8; ++j) { const int p = p0 + j; const size_t pi = (((size_t)l * 2 + d) * 16 + g) * 64 + p; const float lr = LP[pi * 66 + 2 * e], li = LP[pi * 66 + 2 * e + 1];
                  const float zr = cre[p] * lr - cim[p] * li, zi = cre[p] * li + cim[p] * lr; v[j] = part == 0 ? zr : -zi; } }
          u32x4 w; w.x = pk2(v[0], v[1]); w.y = pk2(v[2], v[3]); w.z = pk2(v[4], v[5]); w.w = pk2(v[6], v[7]);
          *(u32x4*)(W2 + (((size_t)l * 16 + g) * 512 + n) * 768 + kc * 8) = w; } }
}

__device__ __forceinline__ void norm_emit_phase(const Ctx& C, const float* xlat, const float* xctx, const float* gain, const float* modl  , bf16* hn, float* ssq, int nrows) {
    const int gw = C.bid * 8 + C.wave, NGW = C.G * 8;
    auto rowp = [&](int r) -> const f32x4* { return (const f32x4*)(r < MLAT ? xlat + (size_t)r * DM : xctx + (size_t)(r - MLAT) * DM) + C.lane; };
    f32x4 v[4], nv[4];
    { const f32x4* x4 = rowp(gw < nrows ? gw : 0);
#pragma unroll
      for (int q = 0; q < 4; ++q) v[q] = x4[64 * q]; }
    for (int r = gw; r < nrows; r += NGW) {
        { const f32x4* n4 = rowp(r + NGW < nrows ? r + NGW : r);
#pragma unroll
          for (int q = 0; q < 4; ++q) nv[q] = n4[64 * q]; }
        const int j = r < MLAT ? (r >> 13) : 8; float s = 0.f;
#pragma unroll
        for (int q = 0; q < 4; ++q) s += (v[q].x * v[q].x + v[q].y * v[q].y) + (v[q].z * v[q].z + v[q].w * v[q].w);
        s = wave_sum(s);
        if (C.lane == 0) ssq[r] = s;
        const float* sv = modl + (size_t)j * 6144 + 1024;
        unsigned long long* o8 = (unsigned long long*)(hn + (size_t)r * DM) + C.lane;
#pragma unroll
        for (int q = 0; q < 4; ++q) { const f32x4 y = v[q] * (*(const f32x4*)(gain + 4 * C.lane + 256 * q) * (*(const f32x4*)(sv + 4 * C.lane + 256 * q) + 1.0f));
            o8[64 * q] = (unsigned long long)pk2(y.x, y.y) | ((unsigned long long)pk2(y.z, y.w) << 32); }
#pragma unroll
        for (int q = 0; q < 4; ++q) v[q] = nv[q];
    }
}
__device__ __forceinline__ void final_norm_phase(const Ctx& C, float* x, const float* gain) {
    const int gw = C.bid * 8 + C.wave, NGW = C.G * 8;
    f32x4 v[4], nv[4];
    { const f32x4* x4 = (const f32x4*)(x + (size_t)(gw < MLAT ? gw : 0) * DM) + C.lane;
#pragma unroll
      for (int q = 0; q < 4; ++q) v[q] = x4[64 * q]; }
    f32x4 gg[4];
#pragma unroll
    for (int q = 0; q < 4; ++q) gg[q] = *(const f32x4*)(gain + 4 * C.lane + 256 * q);
    for (int r = gw; r < MLAT; r += NGW) {
        { const f32x4* n4 = (const f32x4*)(x + (size_t)(r + NGW < MLAT ? r + NGW : r) * DM) + C.lane;
#pragma unroll
          for (int q = 0; q < 4; ++q) nv[q] = n4[64 * q]; }
        float s = 0.f;
#pragma unroll
        for (int q = 0; q < 4; ++q) s += (v[q].x * v[q].x + v[q].y * v[q].y) + (v[q].z * v[q].z + v[q].w * v[q].w);
        const float rs = 1.0f / sqrtf(wave_sum(s) * (1.0f / DM) + NORM_EPS);
        f32x4* x4 = (f32x4*)(x + (size_t)r * DM) + C.lane;
#pragma unroll
        for (int q = 0; q < 4; ++q) x4[64 * q] = v[q] * rs * gg[q];
#pragma unroll
        for (int q = 0; q < 4; ++q) v[q] = nv[q];
    }
}
__device__ __forceinline__ void rope_phase(const Ctx& C) {
    bf16* z1 = WSP(bf16, WS_Z1); const float* rt = WSP(float, WS_ROPE);
    constexpr long total = (long)MLAT * 40, NT = (long)GRID * 512; static_assert(total % (4 * NT) == 0, "four items per thread and trip");
    for (long i0 = (long)C.bid * 512 + C.tid; i0 < total; i0 += 4 * NT) {
        bf16* p[4]; const float* cs[4]; u32x4 a[4], b[4];
#pragma unroll
        for (int u = 0; u < 4; ++u) { const long i = i0 + u * NT;
            const int e = (int)(i % 40); const int row = (int)(i / 40); const int head = e >> 2, half = (e >> 1) & 1, ic = e & 1; const int t = row & 8191;
            p[u] = z1 + (size_t)row * ZP + (head < 8 ? head * 64 : 512 + (head - 8) * 64) + half * 32 + ic * 8;
            const int pos = half == 0 ? (t >> 6) : (t & 63); cs[u] = rt + (pos * 16 + ic * 8) * 2;
            a[u] = *(const u32x4*)p[u]; b[u] = *(const u32x4*)(p[u] + 16); }
#pragma unroll
        for (int u = 0; u < 4; ++u) {
            const unsigned aw[4] = {a[u].x, a[u].y, a[u].z, a[u].w}, bw[4] = {b[u].x, b[u].y, b[u].z, b[u].w}; unsigned oa[4], ob[4];
#pragma unroll
            for (int q = 0; q < 4; ++q) { const f32x4 c4 = *(const f32x4*)(cs[u] + 4 * q); const float c0 = c4.x, s0 = c4.y, c1 = c4.z, s1 = c4.w;
                const float u10 = bflo(aw[q]), u11 = bfhi(aw[q]), u20 = bflo(bw[q]), u21 = bfhi(bw[q]);
                oa[q] = pk2(u10 * c0 - u20 * s0, u11 * c1 - u21 * s1); ob[q] = pk2(u20 * c0 + u10 * s0, u21 * c1 + u11 * s1); }
            u32x4 wa, wb; wa.x = oa[0]; wa.y = oa[1]; wa.z = oa[2]; wa.w = oa[3]; wb.x = ob[0]; wb.y = ob[1]; wb.z = ob[2]; wb.w = ob[3];
            *(u32x4*)p[u] = wa; *(u32x4*)(p[u] + 16) = wb; }
    }
}
__device__ __forceinline__ void conv_phase(const Ctx& C, const bf16* u, bf16* act, const float* cw, const float* cb, int rbase, int nrows) {
    const long total = (long)(nrows / 32) * (DFF / 8);
    for (long i = (long)C.bid * 512 + C.tid; i < total; i += (long)C.G * 512) {
        const int jc = (int)(i % (DFF / 8)), blk = (int)(i / (DFF / 8)); const int rl0 = blk * 32, r0 = rbase + rl0, j0 = jc * 8;
        const int t0 = r0 < MLAT ? (r0 & 8191) : ((r0 - MLAT) & 255); const int len = r0 < MLAT ? 8192 : 256;
        float wa[3][8], wv[3][8], ba[8], bv[8];
#pragma unroll
        for (int h = 0; h < 2; ++h) {
#pragma unroll
            for (int k = 0; k < 3; ++k) { const f32x4 x = *(const f32x4*)(cw + k * NUP + j0 + 4 * h), y = *(const f32x4*)(cw + k * NUP + DFF + j0 + 4 * h);
#pragma unroll
                for (int e = 0; e < 4; ++e) { wa[k][4 * h + e] = x[e]; wv[k][4 * h + e] = y[e]; } }
            const f32x4 x = *(const f32x4*)(cb + j0 + 4 * h), y = *(const f32x4*)(cb + DFF + j0 + 4 * h);
#pragma unroll
            for (int e = 0; e < 4; ++e) { ba[4 * h + e] = x[e]; bv[4 * h + e] = y[e]; } }
        const bf16* ua = u + (size_t)rl0 * NUP + j0; bf16* ap = act + (size_t)rl0 * DFF + j0;
        const u32x4 z = {0u, 0u, 0u, 0u};
        u32x4 pa = t0 > 0 ? *(const u32x4*)(ua - NUP) : z, pv = t0 > 0 ? *(const u32x4*)(ua - NUP + DFF) : z;
        u32x4 ca = *(const u32x4*)ua, cv = *(const u32x4*)(ua + DFF);
        for (int k0 = 0; k0 < 32; k0 += 4) {
            u32x4 na[4], nv[4];
#pragma unroll
            for (int kk = 0; kk < 4; ++kk) { const int k = k0 + kk; const bool hn = (t0 + k) < len - 1;
                na[kk] = hn ? *(const u32x4*)(ua + (size_t)(k + 1) * NUP) : z; nv[kk] = hn ? *(const u32x4*)(ua + (size_t)(k + 1) * NUP + DFF) : z; }
#pragma unroll
            for (int kk = 0; kk < 4; ++kk) { const int k = k0 + kk;
                const unsigned P[4] = {pa.x, pa.y, pa.z, pa.w}, Cc[4] = {ca.x, ca.y, ca.z, ca.w}, N[4] = {na[kk].x, na[kk].y, na[kk].z, na[kk].w}, PV[4] = {pv.x, pv.y, pv.z, pv.w}, CV[4] = {cv.x, cv.y, cv.z, cv.w}, NV[4] = {nv[kk].x, nv[kk].y, nv[kk].z, nv[kk].w};
                unsigned o[4];
#pragma unroll
                for (int q = 0; q < 4; ++q) {
                    const float a0 = bflo(P[q]) * wa[0][2 * q] + bflo(Cc[q]) * wa[1][2 * q] + bflo(N[q]) * wa[2][2 * q] + ba[2 * q];
                    const float a1 = bfhi(P[q]) * wa[0][2 * q + 1] + bfhi(Cc[q]) * wa[1][2 * q + 1] + bfhi(N[q]) * wa[2][2 * q + 1] + ba[2 * q + 1];
                    const float v0 = bflo(PV[q]) * wv[0][2 * q] + bflo(CV[q]) * wv[1][2 * q] + bflo(NV[q]) * wv[2][2 * q] + bv[2 * q];
                    const float v1 = bfhi(PV[q]) * wv[0][2 * q + 1] + bfhi(CV[q]) * wv[1][2 * q + 1] + bfhi(NV[q]) * wv[2][2 * q + 1] + bv[2 * q + 1];
                    o[q] = pk2(a0 * sigmoidf_(a0) * v0, a1 * sigmoidf_(a1) * v1); }
                u32x4 w; w.x = o[0]; w.y = o[1]; w.z = o[2]; w.w = o[3];
                *(u32x4*)(ap + (size_t)k * DFF) = w;
                pa = ca; ca = na[kk]; pv = cv; cv = nv[kk]; }
        }
    }
}

__device__ __forceinline__ void seam_phase(const Ctx& C, const float* raw, bf16* act, const float* cw, const float* cb, int ntiles) {
    const long total = (long)ntiles * 2 * (DFF / 8);
    for (long i = (long)C.bid * 512 + C.tid; i < total; i += (long)C.G * 512) {
        const int jc = (int)(i % (DFF / 8)); const int rr = (int)(i / (DFF / 8)); const int pm = rr >> 1, last = rr & 1; const int ch = jc * 8, pn = ch >> 7, ci = ch & 127;
        const int r = pm * 256 + (last ? 255 : 0); const int t = r < MLAT ? (r & 8191) : ((r - MLAT) & 255); const int len = r < MLAT ? 8192 : 256;
        const float* base = raw + (size_t)pm * 4 * NUP + pn * 256 + ci;
        const float* pp = last ? base + 2 * NUP : (t > 0 ? base - 4 * NUP + 3 * NUP : nullptr);
        const float* cp = last ? base + 3 * NUP : base;
        const float* np = last ? (t < len - 1 ? base + 4 * NUP : nullptr) : base + NUP;
        float res[8];
#pragma unroll
        for (int h = 0; h < 2; ++h) {
            f32x4 A[3], V[3]; const f32x4 z = {0.f, 0.f, 0.f, 0.f};
            A[0] = pp ? *(const f32x4*)(pp + 4 * h) : z; V[0] = pp ? *(const f32x4*)(pp + 128 + 4 * h) : z;
            A[1] = *(const f32x4*)(cp + 4 * h); V[1] = *(const f32x4*)(cp + 128 + 4 * h);
            A[2] = np ? *(const f32x4*)(np + 4 * h) : z; V[2] = np ? *(const f32x4*)(np + 128 + 4 * h) : z;
            f32x4 a = *(const f32x4*)(cb + ch + 4 * h), v = *(const f32x4*)(cb + DFF + ch + 4 * h);
#pragma unroll
            for (int k = 0; k < 3; ++k) { a += A[k] * *(const f32x4*)(cw + k * NUP + ch + 4 * h); v += V[k] * *(const f32x4*)(cw + k * NUP + DFF + ch + 4 * h); }
#pragma unroll
            for (int e = 0; e < 4; ++e) res[4 * h + e] = a[e] * sigmoidf_(a[e]) * v[e];
        }
        u32x4 w; w.x = pk2(res[0], res[1]); w.y = pk2(res[2], res[3]); w.z = pk2(res[4], res[5]); w.w = pk2(res[6], res[7]);
        *(u32x4*)(act + (size_t)r * DFF + ch) = w;
    }
}

__device__ __forceinline__ f32x16 mfma32(bf16x8 a, bf16x8 b, f32x16 c) { return __builtin_amdgcn_mfma_f32_32x32x16_bf16(a, b, c, 0, 0, 0); }
__device__ __forceinline__ void attn_unit(const Ctx& C, bf16* z1, const float* sinkp, int b, int kvh, int q0, bool isctx) {
    constexpr int KB = 64 * 72 * 2, VB = 64 * 68 * 2, BUF = KB + VB + 64;
    const int w = C.wave, lane = C.lane, g = w >> 1, th = w & 1, c = lane & 31, hh = lane >> 5;
    const int qtok = q0 + th * 32 + c;
    const size_t qrow = isctx ? (size_t)MLAT + b * 256 + qtok : (size_t)b * 8192 + qtok;
    bf16* qptr = z1 + qrow * ZP + kvh * 256 + g * 64;
    int first = 0, nloc = 0;
    if (!isctx) { first = q0 >= 128 ? 0 : (q0 >= 64 ? 1 : 2); const int last = q0 + 128 < SEQ ? 4 : (q0 + 64 < SEQ ? 3 : 2); nloc = last - first + 1; }
    const int nt = nloc + 4;
    const bf16* kvbase = z1 + 512 + kvh * 64 + 8 * w;
    auto tile_row0 = [&](int t, int& kpos0) -> size_t { if (t < nloc) { kpos0 = q0 - 128 + 64 * (first + t); return (size_t)b * 8192 + kpos0; } kpos0 = 64 * (t - nloc); return (size_t)MLAT + b * 256 + kpos0; };
    int kp0; size_t r0 = tile_row0(0, kp0);
    u32x4 kv = *(const u32x4*)(kvbase + (r0 + lane) * ZP), vv = *(const u32x4*)(kvbase + (r0 + lane) * ZP + 128);
    bf16x8 qf[4];
#pragma unroll
    for (int s = 0; s < 4; ++s) qf[s] = *(const bf16x8*)(qptr + 16 * s + 8 * hh);
    const float L2E = 1.4426950408889634f;
    float m_run = sinkp[kvh * 4 + g] * L2E, l_run = hh == 0 ? 1.0f : 0.0f;
    f32x16 ot[2];
#pragma unroll
    for (int i = 0; i < 16; ++i) { ot[0][i] = 0.f; ot[1][i] = 0.f; }
    __syncthreads();
    for (int t = 0; t < nt; ++t) {
        LAS bf16* Ks = (LAS bf16*)(C.lds + (t & 1) * BUF); LAS bf16* VT = (LAS bf16*)(C.lds + (t & 1) * BUF + KB);
        { *(LAS u32x4*)(Ks + lane * 72 + 8 * w) = kv;
          const unsigned vw[4] = {vv.x, vv.y, vv.z, vv.w};
#pragma unroll
          for (int q = 0; q < 4; ++q) { VT[(8 * w + 2 * q) * 68 + lane] = (bf16)(vw[q] & 0xffffu); VT[(8 * w + 2 * q + 1) * 68 + lane] = (bf16)(vw[q] >> 16); } }
        const int kpos0 = kp0; const bool edge = t < nloc && (kpos0 == q0 - 128 || kpos0 == q0 + 128);
        if (t + 1 < nt) { r0 = tile_row0(t + 1, kp0); kv = *(const u32x4*)(kvbase + (r0 + lane) * ZP); vv = *(const u32x4*)(kvbase + (r0 + lane) * ZP + 128); }
        __syncthreads();
        f32x16 st[2];
#pragma unroll
        for (int kh = 0; kh < 2; ++kh) {
#pragma unroll
            for (int i = 0; i < 16; ++i) st[kh][i] = 0.f;
#pragma unroll
            for (int s = 0; s < 4; ++s) { const bf16x8 kf = *(const LAS bf16x8*)(Ks + (32 * kh + c) * 72 + 16 * s + 8 * hh); st[kh] = mfma32(kf, qf[s], st[kh]); }
        }
        if (edge) {
            asm volatile("");
#pragma unroll
            for (int kh = 0; kh < 2; ++kh)
#pragma unroll
                for (int i = 0; i < 16; ++i) { const int kp = kpos0 + 32 * kh + (i & 3) + 8 * (i >> 2) + 4 * hh; const int dd = qtok - kp; if (dd > 128 || dd < -128) st[kh][i] = -INFINITY; }
        }
        float mx = -INFINITY;
#pragma unroll
        for (int kh = 0; kh < 2; ++kh)
#pragma unroll
            for (int i = 0; i < 16; ++i) mx = fmaxf(mx, st[kh][i]);
        mx = fmaxf(mx, __shfl_xor(mx, 32));
        if (__builtin_amdgcn_ballot_w64(mx > m_run + 8.0f) != 0ull) {
            const float m_new = fmaxf(m_run, mx); const float alpha = __builtin_amdgcn_exp2f(m_run - m_new); m_run = m_new; l_run *= alpha;
#pragma unroll
            for (int i = 0; i < 16; ++i) { ot[0][i] *= alpha; ot[1][i] *= alpha; } }
        { const f32x16 d0 = st[0] - m_run, d1 = st[1] - m_run;
#pragma unroll
          for (int i = 0; i < 16; ++i) { st[0][i] = __builtin_amdgcn_exp2f(d0[i]); st[1][i] = __builtin_amdgcn_exp2f(d1[i]); } }
        const f32x16 s16 = st[0] + st[1]; const f32x8 s8 = s16.lo + s16.hi; const f32x4 s4 = s8.lo + s8.hi;
        l_run += (s4.x + s4.y) + (s4.z + s4.w);
#pragma unroll
        for (int kh = 0; kh < 2; ++kh)
#pragma unroll
            for (int s2 = 0; s2 < 2; ++s2) {
                u32x4 pw; pw.x = pk2(st[kh][8 * s2 + 0], st[kh][8 * s2 + 1]); pw.y = pk2(st[kh][8 * s2 + 2], st[kh][8 * s2 + 3]); pw.z = pk2(st[kh][8 * s2 + 4], st[kh][8 * s2 + 5]); pw.w = pk2(st[kh][8 * s2 + 6], st[kh][8 * s2 + 7]);
                const bf16x8 pf = __builtin_bit_cast(bf16x8, pw);
#pragma unroll
                for (int db = 0; db < 2; ++db) { const LAS bf16* vp = VT + (32 * db + c) * 68 + 32 * kh + 16 * s2 + 4 * hh;
                    const u32x2 lo = *(const LAS u32x2*)vp, hi = *(const LAS u32x2*)(vp + 8); u32x4 vw2; vw2.x = lo.x; vw2.y = lo.y; vw2.z = hi.x; vw2.w = hi.y;
                    ot[db] = mfma32(__builtin_bit_cast(bf16x8, vw2), pf, ot[db]); }
            }
    }
    const float lt = l_run + __shfl_xor(l_run, 32); const float inv = 1.0f / lt;
#pragma unroll
    for (int db = 0; db < 2; ++db)
#pragma unroll
        for (int i4 = 0; i4 < 4; ++i4) { u32x2 o; o.x = pk2(ot[db][4 * i4] * inv, ot[db][4 * i4 + 1] * inv); o.y = pk2(ot[db][4 * i4 + 2] * inv, ot[db][4 * i4 + 3] * inv);
            *(u32x2*)(qptr + 32 * db + 8 * i4 + 4 * hh) = o; }
}

__device__ __forceinline__ void ml_gate_tables(const Ctx& C, LAS float* tab, float g_i, float g_f) {
    if (C.wave < 2) { const int dir = C.wave, s = C.lane;
        const float lf = g_f; const float ig = g_i;
        float cs = lf;
#pragma unroll
        for (int o = 1; o < 64; o <<= 1) { const float nb = dir == 0 ? __shfl_up(cs, o) : __shfl_down(cs, o); const bool ok = dir == 0 ? (s >= o) : (s + o < 64); cs += ok ? nb : 0.f; }
        tab[dir * 192 + s] = cs; tab[dir * 192 + 64 + s] = ig - cs;
        const float tot = __shfl(cs, dir == 0 ? 63 : 0); if (s == 0) tab[dir * 192 + 128] = tot; }
}
struct MlaIn { u32x4 kv, vv; float gi0, gf0, gi1, gf1; };
__device__ __forceinline__ void mlA_load(const Ctx& C, int cidx, int h, MlaIn& R) {
    const bf16* z1 = WSP(bf16, WS_Z1); const float* gm = WSP(float, WS_GM); const int r0 = cidx * 64;
    const bf16* kp = z1 + (size_t)(r0 + C.lane) * ZP + 1024 + h * 64 + 8 * C.wave;
    R.kv = *(const u32x4*)kp; R.vv = *(const u32x4*)(kp + 256);
    const float* gr = gm + (size_t)(r0 + C.lane) * 16 + h; R.gi0 = gr[0]; R.gf0 = gr[4]; R.gi1 = gr[8]; R.gf1 = gr[12];
}
__device__ __forceinline__ void mlA_compute(const Ctx& C, int l, int cidx, int h, const MlaIn& R, int par) {
    LAS unsigned char* base = C.lds + par * 32768;
    LAS float* tab = (LAS float*)base;
    LAS bf16* KT = (LAS bf16*)(base + 2048);
    LAS bf16* VF = (LAS bf16*)(base + 2048 + 9216);
    LAS bf16* VB = (LAS bf16*)(base + 2048 + 2 * 9216);
    const int w = C.wave, lane = C.lane;
    const u32x4 kv = R.kv, vv = R.vv;
    float csf = R.gf0, csb = R.gf1;
#pragma unroll
    for (int o = 1; o < 64; o <<= 1) { const float nf = __shfl_up(csf, o), nb = __shfl_down(csb, o); csf += lane >= o ? nf : 0.f; csb += lane + o < 64 ? nb : 0.f; }
    const float totf = __shfl(csf, 63), totb = __shfl(csb, 0);
    { const float wf = __expf(totf + (R.gi0 - csf)), wb = __expf(totb + (R.gi1 - csb));
      const unsigned kw[4] = {kv.x, kv.y, kv.z, kv.w}, vw[4] = {vv.x, vv.y, vv.z, vv.w};
#pragma unroll
      for (int q = 0; q < 4; ++q) { const int d0 = 8 * w + 2 * q;
          KT[d0 * 72 + lane] = (bf16)(kw[q] & 0xffffu); KT[(d0 + 1) * 72 + lane] = (bf16)(kw[q] >> 16);
          const float v0 = bflo(vw[q]), v1 = bfhi(vw[q]);
          VF[d0 * 72 + lane] = f2bf(v0 * wf); VF[(d0 + 1) * 72 + lane] = f2bf(v1 * wf);
          VB[d0 * 72 + lane] = f2bf(v0 * wb); VB[(d0 + 1) * 72 + lane] = f2bf(v1 * wb); }
      if (w == 0) { tab[lane] = wf; tab[64 + lane] = wb; if (lane == 0) { tab[128] = totf; tab[129] = totb; } } }
    __syncthreads();
    const int dir = w >> 2, dblk = (w >> 1) & 1, eblk = w & 1, c = lane & 31, hh = lane >> 5;
    const LAS bf16* VX = dir == 0 ? VF : VB;
    f32x16 acc;
#pragma unroll
    for (int i = 0; i < 16; ++i) acc[i] = 0.f;
#pragma unroll
    for (int s = 0; s < 4; ++s) { const bf16x8 a = *(const LAS bf16x8*)(KT + (32 * dblk + c) * 72 + 16 * s + 8 * hh), bb = *(const LAS bf16x8*)(VX + (32 * eblk + c) * 72 + 16 * s + 8 * hh); acc = mfma32(a, bb, acc); }
    const size_t idx = ((size_t)cidx * 4 + h) * 2 + dir;
    bf16* dc = WSP(bf16, WS_DC) + idx * 4096 + (32 * eblk + c) * 64 + 32 * dblk + 4 * hh;
#pragma unroll
    for (int i4 = 0; i4 < 4; ++i4) { u32x2 o; o.x = pk2(acc[4 * i4], acc[4 * i4 + 1]); o.y = pk2(acc[4 * i4 + 2], acc[4 * i4 + 3]); *(u32x2*)(dc + 8 * i4) = o; }
    if (C.tid < 128) { const int dd = C.tid >> 6, d = C.tid & 63; float s = 0.f;
#pragma unroll
        for (int k8 = 0; k8 < 8; ++k8) { const u32x4 kk = *(const LAS u32x4*)(KT + d * 72 + 8 * k8); const LAS float* wp = tab + dd * 64 + 8 * k8; const f32x4 w0 = *(const LAS f32x4*)wp, w1 = *(const LAS f32x4*)(wp + 4);
            s += ((w0[0] * bflo(kk.x) + w0[1] * bfhi(kk.x)) + (w0[2] * bflo(kk.y) + w0[3] * bfhi(kk.y))) + ((w1[0] * bflo(kk.z) + w1[1] * bfhi(kk.z)) + (w1[2] * bflo(kk.w) + w1[3] * bfhi(kk.w))); }
        WSP(float, WS_DN)[(((size_t)cidx * 4 + h) * 2 + dd) * 64 + d] = s;
        if (d == 0) WSP(float, WS_BEND)[((size_t)cidx * 4 + h) * 2 + dd] = tab[128 + dd]; }
}
__device__ __forceinline__ void ml_carry_unit(const Ctx& C, int chain) {
    const int dir = chain & 1, h = (chain >> 1) & 3, b = chain >> 3;
    const bf16* DCp = WSP(bf16, WS_DC); bf16* CIN = WSP(bf16, WS_CIN); const float* DN = WSP(float, WS_DN); float* NINp = WSP(float, WS_NIN); const float* BEND = WSP(float, WS_BEND);
    float zz = 0.f; asm volatile("" : "+v"(zz));
    float st[8]; float ns = zz;
#pragma unroll
    for (int j = 0; j < 8; ++j) st[j] = zz;
    const int nl = C.tid & 63;
    size_t idx[4], nidx[4]; u32x4 dv[4], ndv[4]; float be[4], dn[4], nbe[4], ndn[4];
#define MLC_LOAD(S0, IDX, DV, BE, DNV) _Pragma("unroll") for (int k = 0; k < 4; ++k) { const int step = (S0) + k; const int cidx = (S0) == 0 ? 1024 + b * 4 + (dir == 0 ? step : 3 - step) : b * 128 + (dir == 0 ? step - 4 : 131 - step); \
            IDX[k] = ((size_t)cidx * 4 + h) * 2 + dir; DV[k] = *(const u32x4*)(DCp + IDX[k] * 4096 + C.tid * 8); BE[k] = BEND[IDX[k]]; DNV[k] = DN[IDX[k] * 64 + nl]; }
    MLC_LOAD(0, idx, dv, be, dn)
    for (int s0 = 0; s0 < 132; s0 += 4) {
        const int sn = s0 + 4 < 132 ? s0 + 4 : s0;
        MLC_LOAD(sn, nidx, ndv, nbe, ndn)
#pragma unroll
        for (int k = 0; k < 4; ++k) {
            u32x4 o; o.x = pk2(st[0], st[1]); o.y = pk2(st[2], st[3]); o.z = pk2(st[4], st[5]); o.w = pk2(st[6], st[7]);
            *(u32x4*)(CIN + idx[k] * 4096 + C.tid * 8) = o;
            const float dec = __expf(be[k]);
            st[0] = dec * st[0] + bflo(dv[k].x); st[1] = dec * st[1] + bfhi(dv[k].x); st[2] = dec * st[2] + bflo(dv[k].y); st[3] = dec * st[3] + bfhi(dv[k].y);
            st[4] = dec * st[4] + bflo(dv[k].z); st[5] = dec * st[5] + bfhi(dv[k].z); st[6] = dec * st[6] + bflo(dv[k].w); st[7] = dec * st[7] + bfhi(dv[k].w);
            if (C.tid < 64) NINp[idx[k] * 64 + C.tid] = ns;
            ns = dec * ns + dn[k];
        }
#pragma unroll
        for (int k = 0; k < 4; ++k) { idx[k] = nidx[k]; dv[k] = ndv[k]; be[k] = nbe[k]; dn[k] = ndn[k]; }
    }
#undef MLC_LOAD
}
struct MlcIn { u32x4 vv, kk, qq, c0, c1, ogate; f32x4 ng0, ng1; float g_i, g_f, nin; };
__device__ __forceinline__ void mlC_load(const Ctx& C, int l, int cidx, int h, MlcIn& R) {
    const bf16* z1 = WSP(bf16, WS_Z1); const float* gm = WSP(float, WS_GM);
    const int r0 = cidx * 64, w = C.wave, lane = C.lane;
    const bf16* rp = z1 + (size_t)(r0 + lane) * ZP + h * 64 + 8 * w;
    R.qq = *(const u32x4*)(rp + 768); R.kk = *(const u32x4*)(rp + 1024); R.vv = *(const u32x4*)(rp + 1280);
    { const int row = C.tid >> 2, ch = C.tid & 3; const bf16* cp = WSP(bf16, WS_CIN) + (((size_t)cidx * 4 + h) * 2 + (row >> 6)) * 4096 + (row & 63) * 64 + 16 * ch; R.c0 = *(const u32x4*)cp; R.c1 = *(const u32x4*)(cp + 8); }
    R.ogate = *(const u32x4*)(z1 + (size_t)(r0 + (C.tid >> 3)) * ZP + 1536 + h * 64 + (C.tid & 7) * 8);
    const float* ng = INP(22) + l * 256 + h * 64 + (C.tid & 7) * 8; R.ng0 = *(const f32x4*)ng; R.ng1 = *(const f32x4*)(ng + 4);
    const float* gr = gm + (size_t)(r0 + lane) * 16 + (w & 1) * 8 + h; R.g_i = gr[0]; R.g_f = gr[4];
    R.nin = WSP(float, WS_NIN)[(((size_t)cidx * 4 + h) * 2 + ((C.tid >> 6) & 1)) * 64 + lane];
}
__device__ __forceinline__ void mlC_compute(const Ctx& C, int l, int cidx, int h, const MlcIn& R, int par) {
    bf16* z1 = WSP(bf16, WS_Z1);
    LAS unsigned char* base = C.lds + par * 64256;
    LAS float* tab = (LAS float*)base;
    LAS bf16* VT = (LAS bf16*)(base + 2048);
    LAS float* Hs = (LAS float*)(base + 2048 + 8704);
    LAS bf16* Ks = (LAS bf16*)(base + 27392);
    LAS bf16* Qs = (LAS bf16*)(base + 27392 + 9216);
    LAS bf16* Cs = (LAS bf16*)(base + 27392 + 2 * 9216);
    const int r0 = cidx * 64, w = C.wave, lane = C.lane;
    const int dir = w >> 2, eblk = (w >> 1) & 1, tblk = w & 1, c = lane & 31, hh = lane >> 5; const int t = 32 * tblk + c;
    ml_gate_tables(C, tab, R.g_i, R.g_f);
    if (C.tid < 128) tab[384 + C.tid] = R.nin;
    { const unsigned vw[4] = {R.vv.x, R.vv.y, R.vv.z, R.vv.w};
#pragma unroll
      for (int q = 0; q < 4; ++q) { VT[(8 * w + 2 * q) * 68 + lane] = (bf16)(vw[q] & 0xffffu); VT[(8 * w + 2 * q + 1) * 68 + lane] = (bf16)(vw[q] >> 16); }
      *(LAS u32x4*)(Ks + lane * 72 + 8 * w) = R.kk; *(LAS u32x4*)(Qs + lane * 72 + 8 * w) = R.qq;
      const int row = C.tid >> 2, ch = C.tid & 3; *(LAS u32x4*)(Cs + row * 72 + 16 * ch) = R.c0; *(LAS u32x4*)(Cs + row * 72 + 16 * ch + 8) = R.c1; }
    __syncthreads();
    bf16x8 qf[4];
#pragma unroll
    for (int s = 0; s < 4; ++s) qf[s] = *(const LAS bf16x8*)(Qs + t * 72 + 16 * s + 8 * hh);
    const float bct = tab[dir * 192 + t];
    float nq = 0.f;
#pragma unroll
    for (int s = 0; s < 4; ++s) { const u32x4 qw = __builtin_bit_cast(u32x4, qf[s]); const LAS float* np = tab + 384 + dir * 64 + 16 * s + 8 * hh; const f32x4 n0 = *(const LAS f32x4*)np, n1 = *(const LAS f32x4*)(np + 4);
        nq += n0[0] * bflo(qw.x) + n0[1] * bfhi(qw.x) + n0[2] * bflo(qw.y) + n0[3] * bfhi(qw.y) + n1[0] * bflo(qw.z) + n1[1] * bfhi(qw.z) + n1[2] * bflo(qw.w) + n1[3] * bfhi(qw.w); }
    nq += __shfl_xor(nq, 32);
    f32x16 acc, acc2;
#pragma unroll
    for (int i = 0; i < 16; ++i) { acc[i] = 0.f; acc2[i] = 0.f; }
    float dsum = 0.f;
#pragma unroll
    for (int sb = 0; sb < 2; ++sb) {
        f32x16 st;
#pragma unroll
        for (int i = 0; i < 16; ++i) st[i] = 0.f;
#pragma unroll
        for (int s = 0; s < 4; ++s) { const bf16x8 kf = *(const LAS bf16x8*)(Ks + (32 * sb + c) * 72 + 16 * s + 8 * hh); st = mfma32(kf, qf[s], st); }
#pragma unroll
        for (int j = 0; j < 4; ++j) { const f32x4 tv = *(const LAS f32x4*)(tab + dir * 192 + 64 + 32 * sb + 8 * j + 4 * hh);
#pragma unroll
            for (int e = 0; e < 4; ++e) { const int i = 4 * j + e, s = 32 * sb + e + 8 * j + 4 * hh; const bool ok = dir == 0 ? (s <= t) : (s >= t);
                const float wgt = __expf(ok ? bct + tv[e] : -INFINITY); const float p = wgt * st[i]; st[i] = p; dsum += p; } }
#pragma unroll
        for (int s2 = 0; s2 < 2; ++s2) {
            u32x4 pw; pw.x = pk2(st[8 * s2 + 0], st[8 * s2 + 1]); pw.y = pk2(st[8 * s2 + 2], st[8 * s2 + 3]); pw.z = pk2(st[8 * s2 + 4], st[8 * s2 + 5]); pw.w = pk2(st[8 * s2 + 6], st[8 * s2 + 7]);
            const LAS bf16* vp = VT + (32 * eblk + c) * 68 + 32 * sb + 16 * s2 + 4 * hh;
            const u32x2 lo = *(const LAS u32x2*)vp, hi = *(const LAS u32x2*)(vp + 8); u32x4 vw; vw.x = lo.x; vw.y = lo.y; vw.z = hi.x; vw.w = hi.y;
            acc = mfma32(__builtin_bit_cast(bf16x8, vw), __builtin_bit_cast(bf16x8, pw), acc); }
    }
#pragma unroll
    for (int s = 0; s < 4; ++s) { const bf16x8 cf = *(const LAS bf16x8*)(Cs + (dir * 64 + 32 * eblk + c) * 72 + 16 * s + 8 * hh); acc2 = mfma32(cf, qf[s], acc2); }
    dsum += __shfl_xor(dsum, 32);
    const float eb = __expf(bct); const float den = dsum + eb * nq; const float rden = 1.0f / fmaxf(fabsf(den), 1.0f);
    if (dir == 0) {
#pragma unroll
        for (int i = 0; i < 16; ++i) Hs[t * 65 + 32 * eblk + (i & 3) + 8 * (i >> 2) + 4 * hh] = (acc[i] + eb * acc2[i]) * rden; }
    __syncthreads();
    if (dir == 1) {
#pragma unroll
        for (int i = 0; i < 16; ++i) Hs[t * 65 + 32 * eblk + (i & 3) + 8 * (i >> 2) + 4 * hh] += (acc[i] + eb * acc2[i]) * rden; }
    __syncthreads();
    { const int tt = C.tid >> 3, e0 = (C.tid & 7) * 8; float hv[8]; float ss = 0.f;
#pragma unroll
      for (int j = 0; j < 8; ++j) { hv[j] = Hs[tt * 65 + e0 + j]; ss += hv[j] * hv[j]; }
      ss += __shfl_xor(ss, 1); ss += __shfl_xor(ss, 2); ss += __shfl_xor(ss, 4);
      const float rs = 1.0f / sqrtf(ss * (1.0f / 64.0f) + NORM_EPS);
      bf16* rowp = z1 + (size_t)(r0 + tt) * ZP; const unsigned ow[4] = {R.ogate.x, R.ogate.y, R.ogate.z, R.ogate.w};
      const float ng[8] = {R.ng0[0], R.ng0[1], R.ng0[2], R.ng0[3], R.ng1[0], R.ng1[1], R.ng1[2], R.ng1[3]}; unsigned o[4];
#pragma unroll
      for (int q = 0; q < 4; ++q) o[q] = pk2(hv[2 * q] * rs * ng[2 * q] * sigmoidf_(bflo(ow[q])), hv[2 * q + 1] * rs * ng[2 * q + 1] * sigmoidf_(bfhi(ow[q])));
      u32x4 wv; wv.x = o[0]; wv.y = o[1]; wv.z = o[2]; wv.w = o[3];
      *(u32x4*)(rowp + 768 + h * 64 + e0) = wv; }
}
__device__ __forceinline__ void s5_carry_unit(const Ctx& C, int l, int unit) {
    const int x = unit * 512 + C.tid; const int p = x & 63, d = (x >> 6) & 1, g = (x >> 7) & 15, b = x >> 11;
    const float* lp = WSP(float, WS_LP) + ((((size_t)l * 2 + d) * 16 + g) * 64 + p) * 66; const float lr = lp[64], li = lp[65];
    const float* E = WSP(float, WS_E); bf16* A2 = WSP(bf16, WS_A2);
    float sr = 0.f; asm volatile("" : "+v"(sr)); float si = sr;
    size_t row[8], nrow[8]; float er[8], ei[8], ner[8], nei[8];
#define S5C_LOAD(S0, ROW, ER, EI) _Pragma("unroll") for (int k = 0; k < 8; ++k) { const int step = (S0) + k; const int ch = (S0) == 0 ? 2048 + b * 8 + (d == 0 ? step : 7 - step) : b * 256 + (d == 0 ? step - 8 : 263 - step); \
            ROW[k] = (size_t)g * NCH5P + ch; ER[k] = E[ROW[k] * 256 + (d * 2) * 64 + p]; EI[k] = E[ROW[k] * 256 + (d * 2 + 1) * 64 + p]; }
    S5C_LOAD(0, row, er, ei)
    for (int s0 = 0; s0 < 264; s0 += 8) {
        const int sn = s0 + 8 < 264 ? s0 + 8 : s0;
        S5C_LOAD(sn, nrow, ner, nei)
#pragma unroll
        for (int k = 0; k < 8; ++k) {
            A2[row[k] * A2P + 512 + (d * 2) * 64 + p] = f2bf(sr); A2[row[k] * A2P + 512 + (d * 2 + 1) * 64 + p] = f2bf(si);
            const float nr = lr * sr - li * si + er[k], ni = lr * si + li * sr + ei[k]; sr = nr; si = ni;
        }
#pragma unroll
        for (int k = 0; k < 8; ++k) { row[k] = nrow[k]; er[k] = ner[k]; ei[k] = nei[k]; }
    }
#undef S5C_LOAD
}

constexpr int PH_PER_LAYER = 15, PH_FINAL = 3 + 2 * PH_PER_LAYER, N_PHASES = PH_FINAL + 1;

__global__ void __launch_bounds__(512, 2) skel_fwd(Args args) {
    extern __shared__ __attribute__((aligned(16))) unsigned char lds_raw[];
    Ctx C; C.lds = (LAS unsigned char*)lds_raw; C.tid = threadIdx.x; C.lane = C.tid & 63; C.wave = __builtin_amdgcn_readfirstlane(C.tid >> 6); C.G = GRID; C.bid = blockIdx.x;
    C.ap = kargs();
    volatile LAS unsigned* MISC = (volatile LAS unsigned*)(C.lds + MISC_OFF);
    for (int u = C.tid; u < (LDS_BYTES - RING_BYTES) / 4; u += 512) ((LAS unsigned*)(C.lds + RING_BYTES))[u] = 0u;
    __syncthreads();
    if (C.ap->ph_hi - C.ap->ph_lo > 1) (void)xcd_barrier_post((unsigned*)(C.ap->ws + WS_CTL) + CW_BAR, MISC + 8);
#ifndef PHMASK
#define PHMASK 0xFFFFFFFFu
#endif
#define IN(k) (phase_enter(C) && C.ap->ph_lo <= (k) && (k) < C.ap->ph_hi)
#define EN(j) (((PHMASK) >> (j)) & 1u)
#ifndef DBLMASK
#define DBLMASK 0u
#endif
#define REPS(j) ((((DBLMASK) >> (j)) & 1u) ? 2 : 1)
#define SEAM(k) do { if ((k) + 1 < C.ap->ph_hi) { XcdBarrier bar_; bar_.bar = (unsigned*)(C.ap->ws + WS_CTL) + CW_BAR; bar_.x = xb_xcc_id(); bar_.st = (volatile LAS unsigned*)(C.lds + MISC_OFF) + 8; xcd_barrier(bar_); } } while (0)
#define ring (C.lds)
#define modl (WSP(float, WS_MODV) + (size_t)l * 9 * 6144)
#define xlat_in (l == 0 ? INP(0) : (const float*)OUTP)
#define xctx_in (l == 0 ? INP(2) : (const float*)WSP(float, WS_XC))
#define HN WSP(bf16, WS_HN)
#define Z1 WSP(bf16, WS_Z1)

    if (EN(16) && IN(0)) { for (int rep_ = 0; rep_ < REPS(16); ++rep_) pro0(C); SEAM(0); }
    if (EN(17) && IN(1)) { pro1(C); SEAM(1); }
    if (EN(18) && IN(2)) { pro2(C); norm_emit_phase(C, INP(0), INP(2), INP(6), WSP(float, WS_MODV), WSP(bf16, WS_HN), WSP(float, WS_SSQ), MTOT); SEAM(2); }

    for (int l = 0; l < DEPTH; ++l) {
        const int pb = 3 + l * PH_PER_LAYER;
        const int MP = l == 0 ? MTOT : MLAT;


        if (EN(1) && IN(pb + 1)) for (int rep_ = 0; rep_ < REPS(1); ++rep_) {
            pg8::Gemm g{HN, WSP(bf16, WS_WIN) + (size_t)l * NIN * 1024, MTOT, NIN, 1024, 1024, 1024}; PrefOrder S; S.init(MTOT, NIN, C.G, C.bid);
            S.ssq = WSP(float, WS_SSQ) + (size_t)(2 * l) * MTOT; S.shw = WSP(float, WS_SHWI) + (size_t)l * 9 * NIN; S.ldsh = NIN; S.slot = (LAS float*)(C.lds + PREF_OFF);
            EpiWin E{Z1, WSP(bf16, WS_A2), WSP(float, WS_GM), WSP(unsigned char, WS_GATE), (const LAS float*)(C.lds + PREF_OFF), INP(20) + l * 8, INP(21) + l * 8};
            pg8::gemm_phase<EpiWin, PrefOrder, true, true>(ring, g, S, E);
            SEAM(pb + 1);
        }
        if (EN(2) && IN(pb + 2)) for (int rep_ = 0; rep_ < REPS(2); ++rep_) {
            { pg8::Gemm g{WSP(bf16, WS_A2), WSP(bf16, WS_W1) + (size_t)l * 16 * 256 * 512, 16 * NCH5P, 16 * 256, 512, A2P, 512}; GroupOrder S{16, 9, 1, C.G, C.bid, 9};
              EpiS5E E{WSP(float, WS_E)};
              pg8::gemm_phase<EpiS5E, GroupOrder, true, true>(ring, g, S, E); }
            __syncthreads();
            asm volatile("" : "+v"(C.tid), "+v"(C.lane));
            for (int r2_ = 0; r2_ < REPS(12); ++r2_) {
                const int bid_ = C.bid;
                auto unit_of = [&](int k) -> int { if (bid_ >= 144) return k < 4 ? (bid_ - 144) + 112 * k : 448 + (GRID - 1 - bid_) + GRID * (k - 4); return 448 + (GRID - 1 - bid_) + GRID * k; };
                MlaIn cur, nxt; int k = 0, u = unit_of(0); { const int u0 = u < NCHM * 4 ? u : 0; mlA_load(C, u0 >> 2, u0 & 3, cur); }
                while (u < NCHM * 4) { const int un_ = unit_of(k + 1); const int un = un_ < NCHM * 4 ? un_ : u; mlA_load(C, un >> 2, un & 3, nxt); mlA_compute(C, l, u >> 2, u & 3, cur, k & 1); cur = nxt; u = un_; ++k; }
                __syncthreads(); }
            rope_phase(C);
            SEAM(pb + 2);
        }
        if (EN(3) && IN(pb + 3)) for (int rep_ = 0; rep_ < REPS(3); ++rep_) {
            const int natt = 2048 + (l == 0 ? 64 : 0);
            unsigned* qctr = (unsigned*)(C.ap->ws + WS_CTL) + 8192 + 64 * l;
            volatile LAS unsigned* qslot = (volatile LAS unsigned*)(C.lds + RING_BYTES + 64);
            unsigned qn = C.tid == 0 ? __hip_atomic_fetch_add(qctr, 1u, __ATOMIC_RELAXED, __HIP_MEMORY_SCOPE_AGENT) : 0u;
            for (;;) {
                __syncthreads();
                if (C.tid == 0) *qslot = qn;
                __syncthreads();
                const int u = (int)*qslot; if (u >= 96 + natt) break;
                if (C.tid == 0) qn = __hip_atomic_fetch_add(qctr, 1u, __ATOMIC_RELAXED, __HIP_MEMORY_SCOPE_AGENT);
                if (u < 32) s5_carry_unit(C, l, u);
                else if (u < 96) ml_carry_unit(C, u - 32);
                else { const int a = u - 96;
                    if (a < 2048) attn_unit(C, Z1, INP(9) + l * 8, a >> 8, (a >> 7) & 1, (a & 127) * 64, false);
                    else { const int cx = a - 2048; attn_unit(C, Z1, INP(9) + l * 8, cx >> 3, (cx >> 2) & 1, (cx & 3) * 64, true); } }
            }
            SEAM(pb + 3);
        }
        if (EN(4) && IN(pb + 4)) for (int rep_ = 0; rep_ < REPS(4); ++rep_) {
            { pg8::Gemm g{WSP(bf16, WS_A2), WSP(bf16, WS_W2) + (size_t)l * 16 * 512 * 768, 16 * NCH5P, 16 * 512, 768, A2P, 768}; GroupOrder S{16, l == 0 ? 9 : 8, 2, C.G, C.bid, 9};
              EpiS5Y E{WSP(bf16, WS_YPRE)};
              pg8::gemm_phase<EpiS5Y, GroupOrder, true, true>(ring, g, S, E); }
            __syncthreads();
            asm volatile("" : "+v"(C.tid), "+v"(C.lane));
            const int nml = (l == 0 ? NCHM : 1024) * 4;
            { const int R = l == 0 ? 6 : 0; const int bid_ = C.bid;
              auto unit_of = [&](int k) -> int { if (bid_ >= 32) return k < R ? (bid_ - 32) + 224 * k : R * 224 + (GRID - 1 - bid_) + GRID * (k - R); return R * 224 + (GRID - 1 - bid_) + GRID * k; };
              MlcIn cur, nxt; int k = 0, u = unit_of(0); { const int u0 = u < nml ? u : 0; mlC_load(C, l, u0 >> 2, u0 & 3, cur); }
              while (u < nml) { const int un_ = unit_of(k + 1); const int un = un_ < nml ? un_ : u; mlC_load(C, l, un >> 2, un & 3, nxt); mlC_compute(C, l, u >> 2, u & 3, cur, k & 1); cur = nxt; u = un_; ++k; } }
            SEAM(pb + 4);
        }
        if (EN(5) && IN(pb + 5)) for (int rep_ = 0; rep_ < REPS(5); ++rep_) {
            pg8::Gemm g{WSP(bf16, WS_YPRE), WSP(bf16, WS_WGLU) + (size_t)l * 256 * 256, MP, 256, 256, 256, 256}; pg8::StaticOrder S; S.init(MP, 256, C.G, C.bid);
            EpiGlu E{WSP(bf16, WS_YPRE), Z1 + 512, INP(19) + l * 256, ZP};
            pg8::gemm_phase<EpiGlu, pg8::StaticOrder, true, true>(ring, g, S, E);
            SEAM(pb + 5);
        }
        if (EN(6) && IN(pb + 6)) for (int rep_ = 0; rep_ < REPS(6); ++rep_) {
            pg8::Gemm g{Z1, WSP(bf16, WS_WBA) + (size_t)l * 1024 * 1024, MP, 1024, 1024, ZP, 1024}; pg8::StaticOrder S; S.init(MP, 2048, C.G, C.bid);
            EpiMergeF E{HN, WSP(unsigned char, WS_GATE)};
            pg8::gemm_phase<EpiMergeF, pg8::StaticOrder, true, true, true>(ring, g, S, E);
            SEAM(pb + 6);
        }
        if (EN(7) && IN(pb + 7)) for (int rep_ = 0; rep_ < REPS(7); ++rep_) {
            { pg8::Gemm g{HN, WSP(bf16, WS_WOUT) + (size_t)l * 1024 * 1024, MLAT, 1024, 1024, 1024, 1024}; pg8::StaticOrder S; S.init(MLAT, 1024, C.G, C.bid);
              EpiResid<true> E{xlat_in, xctx_in, OUTP, WSP(float, WS_XC), modl + 2048, 0, WSP(bf16, WS_HN2), WSP(float, WS_GAM) + (size_t)(l * 2 + 1) * 9 * 1024, WSP(float, WS_SSQ) + (size_t)(2 * l + 1) * MTOT};
              pg8::gemm_phase<EpiResid<true>, pg8::StaticOrder, true, true>(ring, g, S, E); }
            if (l == 0) {
                asm volatile("" : "+v"(C.tid), "+v"(C.lane));
                pg8::Gemm g{HN + (size_t)MLAT * 1024, WSP(bf16, WS_WOUT) + (size_t)l * 1024 * 1024, MCTX, 1024, 1024, 1024, 1024}; pg8::StaticOrder S; S.init(MCTX, 2048, C.G, C.bid);
                EpiResid<true, true> E{xlat_in, xctx_in, OUTP, WSP(float, WS_XC), modl + 2048, MLAT, WSP(bf16, WS_HN2), WSP(float, WS_GAM) + (size_t)(l * 2 + 1) * 9 * 1024, WSP(float, WS_SSQ) + (size_t)(2 * l + 1) * MTOT};
                pg8::gemm_phase<EpiResid<true, true>, pg8::StaticOrder, true, true, true>(ring, g, S, E); }
            SEAM(pb + 7);
        }
        if (EN(9) && IN(pb + 9)) {
            pg8::Gemm g{WSP(bf16, WS_HN2), WSP(bf16, WS_WUP) + (size_t)l * NUP * 1024, MP, NUP, 1024, 1024, 1024}; PrefOrder S; S.init(MP, NUP, C.G, C.bid);
            S.ssq = WSP(float, WS_SSQ) + (size_t)(2 * l + 1) * MTOT; S.shw = WSP(float, WS_SHWU) + (size_t)l * 9 * NUP; S.ldsh = NUP; S.slot = (LAS float*)(C.lds + PREF_OFF);
            EpiUpConv E{WSP(bf16, WS_ACT), WSP(float, WS_RAW), (const LAS float*)(C.lds + PREF_OFF), INP(28) + (size_t)l * 3 * NUP, INP(29) + (size_t)l * NUP, (LAS float*)(C.lds + RING_BYTES + 1024)};
            pg8::gemm_phase<EpiUpConv, PrefOrder, true, true>(ring, g, S, E);
            SEAM(pb + 9);
        }
        if (EN(10) && IN(pb + 10)) { seam_phase(C, WSP(float, WS_RAW), WSP(bf16, WS_ACT), INP(28) + (size_t)l * 3 * NUP, INP(29) + (size_t)l * NUP, MP / 256); SEAM(pb + 10); }
        if (EN(11) && IN(pb + 11)) {
            pg8::Gemm g{WSP(bf16, WS_ACT), WSP(bf16, WS_WDN) + (size_t)l * 1024 * DFF, MLAT, 1024, DFF, DFF, DFF}; pg8::StaticOrder S; S.init(MLAT, 1024, C.G, C.bid);
            if (l == 0) { { EpiResid<true> E{OUTP, WSP(float, WS_XC), OUTP, WSP(float, WS_XC), modl + 5120, 0, HN, WSP(float, WS_GAM) + (size_t)2 * 9 * 1024, WSP(float, WS_SSQ) + (size_t)2 * MTOT};
                  pg8::gemm_phase<EpiResid<true>, pg8::StaticOrder, true, true>(ring, g, S, E); }
                asm volatile("" : "+v"(C.tid), "+v"(C.lane));
                pg8::Gemm g2{WSP(bf16, WS_ACT) + (size_t)MLAT * DFF, WSP(bf16, WS_WDN) + (size_t)l * 1024 * DFF, MCTX, 1024, DFF, DFF, DFF}; pg8::StaticOrder S2; S2.init(MCTX, 2048, C.G, C.bid);
                EpiResid<true, true> E2{OUTP, WSP(float, WS_XC), OUTP, WSP(float, WS_XC), modl + 5120, MLAT, HN, WSP(float, WS_GAM) + (size_t)2 * 9 * 1024, WSP(float, WS_SSQ) + (size_t)2 * MTOT};
                pg8::gemm_phase<EpiResid<true, true>, pg8::StaticOrder, true, true, true>(ring, g2, S2, E2); }
            else { EpiResid<false> E{OUTP, WSP(float, WS_XC), OUTP, WSP(float, WS_XC), modl + 5120, 0, nullptr, nullptr, nullptr};
                pg8::gemm_phase<EpiResid<false>, pg8::StaticOrder, true, true>(ring, g, S, E); }
            SEAM(pb + 11);
        }
    }
    if (IN(PH_FINAL)) final_norm_phase(C, OUTP, INP(31));
#undef IN
#undef SEAM
#undef ring
#undef modl
#undef xlat_in
#undef xctx_in
#undef HN
#undef Z1
}


#ifndef MK_SPLIT
#define MK_SPLIT 0
#endif
extern "C" void kernel_launch(void* const* d_in, const int* in_sizes, int n_in, void* d_out, int out_size, void* d_ws, size_t ws_size, hipStream_t stream) {
    static int grid = 0;
    if (grid == 0) {
        if (n_in != 32 || out_size != MLAT * DM || ws_size < WS_END) { fprintf(stderr, "kernel_launch: unexpected problem (n_in %d, out %d, ws %zu, need %zu)\n", n_in, out_size, ws_size, (size_t)WS_END); grid = -1; return; }
        int dev = 0, cus = 0, per_cu = 0;
        if (hipGetDevice(&dev) != hipSuccess || hipDeviceGetAttribute(&cus, hipDeviceAttributeMultiprocessorCount, dev) != hipSuccess) { grid = -1; return; }
        if (hipFuncSetAttribute((const void*)skel_fwd, hipFuncAttributeMaxDynamicSharedMemorySize, LDS_BYTES) != hipSuccess) { fprintf(stderr, "kernel_launch: hipFuncSetAttribute failed\n"); grid = -1; return; }
        if (hipOccupancyMaxActiveBlocksPerMultiprocessor(&per_cu, (const void*)skel_fwd, 512, LDS_BYTES) != hipSuccess || per_cu < 1) fprintf(stderr, "kernel_launch: occupancy query reports %d\n", per_cu);
        (void)hipGetLastError();
        if (cus < GRID) { fprintf(stderr, "kernel_launch: built for a %d-CU device, found %d CUs\n", GRID, cus); grid = -1; return; }
        grid = GRID;
    }
    if (grid < 0) return;
    (void)hipMemsetAsync((char*)d_ws + WS_CTL, 0, ZERO_BYTES, stream);
    Args a{};
    for (int i = 0; i < 32; ++i) a.in[i] = (const float*)d_in[i];
    a.out = (float*)d_out; a.ws = (unsigned char*)d_ws;
#if MK_SPLIT
    for (int ph = 0; ph < N_PHASES; ++ph) { a.ph_lo = ph; a.ph_hi = ph + 1; hipLaunchKernelGGL(skel_fwd, dim3(grid), dim3(512), LDS_BYTES, stream, a); }
#else
    a.ph_lo = 0; a.ph_hi = N_PHASES; hipLaunchKernelGGL(skel_fwd, dim3(grid), dim3(512), LDS_BYTES, stream, a);
#endif
}
```

```cpp
#include <hip/hip_runtime.h>
#include <cstdio>
#include <cstdint>
#include <type_traits>
namespace pg8 {
#define PG8_LAS __attribute__((address_space(3)))
typedef unsigned short bf16_t;
typedef short bf16x8 __attribute__((ext_vector_type(8)));
typedef float f32x4 __attribute__((ext_vector_type(4)));
typedef unsigned u32x4 __attribute__((ext_vector_type(4)));
constexpr int BM = 256, BK = 64, HALF = 128, HTB = HALF * BK * 2  , STAGE_BYTES = 8 * HTB, NXCD = 8, WGM = 4;

__host__ __device__ __forceinline__ int lds_byte(int r, int c) { const int st = (r >> 4) * 2 + (c >> 5), rr = r & 15, cc = c & 31, ob = rr * 64 + cc * 2; return st * 1024 + (ob ^ (((ob >> 9) & 1) << 5)); }
__host__ __device__ __forceinline__ void stage_rc(int b, int& R, int& C) { const int st = b / 1024, sb = b % 1024, swz = sb ^ (((sb >> 9) & 1) << 5); R = (st >> 1) * 16 + swz / 64; C = (st & 1) * 32 + (swz % 64) / 2; }
__host__ __device__ __forceinline__ int perm32(int rho) { const int n = rho >> 4, i = rho & 15; return 8 * (i >> 2) + 4 * n + (i & 3); }

struct Unit { int pm, pn, seq; };
struct Gemm { const bf16_t* A; const bf16_t* Bt; int M, N, K, lda, ldb; };

struct StaticOrder {
    int nM, nN, nwg, G, c;
    __host__ __device__ void init(int M, int N, int G_, int c_) { nM = M / BM; nN = N / BM; nwg = nM * nN; G = G_; c = c_; }
    __host__ __device__ bool next(int i, Unit& u) const {
        const long L = (long)i * G + c; if (L >= nwg) return false;
        int wgid = (int)L; { const int q = nwg / NXCD, r = nwg % NXCD, xcd = wgid % NXCD, off = wgid / NXCD; wgid = (xcd < r ? xcd * (q + 1) : r * (q + 1) + (xcd - r) * q) + off; }
        const int nig = WGM * nN, gid = wgid / nig, fm = gid * WGM, gsz = WGM;
        u.pm = fm + ((wgid % nig) % gsz); u.pn = (wgid % nig) / gsz; u.seq = i; return true;
    }
    __device__ __forceinline__ void a_ready(const Unit&) const {}
    __device__ __forceinline__ void done(const Unit&) const {}
};


struct NoState {};
template <class T, class = void> struct epi_state { typedef NoState type; static constexpr bool has = false; };
template <class T> struct epi_state<T, std::void_t<typename T::State>> { typedef typename T::State type; static constexpr bool has = true; };
template <class T, class = void> struct epi_late { static constexpr bool value = false; };
template <class T> struct epi_late<T, std::void_t<decltype(T::LATE_READY)>> { static constexpr bool value = T::LATE_READY; };
template <class T, class = void> struct epi_nseg { static constexpr int value = 1; };
template <class T> struct epi_nseg<T, std::void_t<typename T::State>> { static constexpr int value = T::NSEG; };
template <class Epi, class Sched, bool ALIGN_EPI = false, bool SP2 = false, bool NHALF = false>
__device__ __forceinline__ void gemm_phase(PG8_LAS unsigned char* lds, const Gemm g, const Sched& S, const Epi& E) {
    int tid_ = threadIdx.x; asm volatile("" : "+v"(tid_));
    const int tid = tid_, wid = __builtin_amdgcn_readfirstlane(tid >> 6), lane = tid & 63, wr = wid >> 2, wc = wid & 3, fr = lane & 15, fq = lane >> 4;
    const int K = g.K, nt = K / BK;
    unsigned voffA[2], voffB[2];
#pragma unroll
    for (int i = 0; i < 2; ++i) { int R, C; stage_rc(tid * 16 + i * 8192, R, C); const int Rb = Epi::PERM ? ((R & ~31) + perm32(R & 31)) : R;
        voffA[i] = (unsigned)(R * g.lda + C) * 2u; voffB[i] = (unsigned)(Rb * g.ldb + C) * 2u; }
    const size_t kstep = (size_t)(BK * 2);
    const size_t hstepA = (size_t)HALF * g.lda * 2, hstepB = (size_t)HALF * g.ldb * 2;
    const size_t tstepA = 2 * hstepA, tstepB = 2 * hstepB;
    const size_t bstep = NHALF ? hstepB : tstepB, bh = NHALF ? 0 : hstepB;
    static_assert(!NHALF || SP2, "NHALF is implemented for the SP2 loop");
    const unsigned ldsw = (unsigned)wid * 1024u;
    const int aoff = lds_byte(wr * 64 + fr, fq * 8), boff = lds_byte(wc * 32 + fr, fq * 8);
#define PG8_SA(b, h) (((b) * 2 + (h)) * HTB)
#define PG8_SB(b, h) ((4 + (b) * 2 + (h)) * HTB)
#define PG8_STAGE(bufoff, gbase, voff) do { _Pragma("unroll") for (int _i = 0; _i < 2; ++_i) \
        __builtin_amdgcn_global_load_lds((const unsigned*)((const char*)(gbase) + (voff)[_i]), (PG8_LAS unsigned*)(lds + (bufoff) + ldsw + _i * 8192), 16, 0, 0); } while (0)
#define PG8_STAGE_NT(bufoff, gbase, voff) do { _Pragma("unroll") for (int _i = 0; _i < 2; ++_i) \
        __builtin_amdgcn_global_load_lds((const unsigned*)((const char*)(gbase) + (voff)[_i]), (PG8_LAS unsigned*)(lds + (bufoff) + ldsw + _i * 8192), 16, 0, 0); } while (0)
#define PG8_LDA(dst, b, h) do { _Pragma("unroll") for (int m = 0; m < 4; ++m) _Pragma("unroll") for (int k = 0; k < 2; ++k) dst[m][k] = *(const PG8_LAS bf16x8*)(lds + PG8_SA(b, h) + aoff + m * 2048 + k * 1024); } while (0)
#define PG8_LDB(dst, b, h) do { _Pragma("unroll") for (int n = 0; n < 2; ++n) _Pragma("unroll") for (int k = 0; k < 2; ++k) dst[n][k] = *(const PG8_LAS bf16x8*)(lds + PG8_SB(b, h) + boff + n * 2048 + k * 1024); } while (0)
#define PG8_MMA(ai, bj, At, Bt) do { __builtin_amdgcn_s_setprio(1); _Pragma("unroll") for (int m = 0; m < 4; ++m) _Pragma("unroll") for (int n = 0; n < 2; ++n) _Pragma("unroll") for (int k = 0; k < 2; ++k) \
        acc[ai][bj][m][n] = __builtin_amdgcn_mfma_f32_16x16x32_bf16(Bt[n][k], At[m][k], acc[ai][bj][m][n], 0, 0, 0); __builtin_amdgcn_s_setprio(0); } while (0)
#define PG8_WAIT_V(n) asm volatile("s_waitcnt vmcnt(" #n ")" ::: "memory")
#define PG8_WAIT_L(n) asm volatile("s_waitcnt lgkmcnt(" #n ")" ::: "memory")
#define PG8_BAR __builtin_amdgcn_s_barrier()
#define PG8_SCHED __builtin_amdgcn_sched_barrier(0)
    Unit cur, nxt; int ui = 0;
    if (!S.next(0, cur)) return;
    f32x4 acc[2][2][4][2];
    typename epi_state<Epi>::type est;
#pragma unroll
    for (int a = 0; a < 2; ++a)
#pragma unroll
        for (int b = 0; b < 2; ++b)
#pragma unroll
            for (int m = 0; m < 4; ++m)
#pragma unroll
                for (int n = 0; n < 2; ++n) acc[a][b][m][n] = (f32x4){0.f, 0.f, 0.f, 0.f};
    bf16x8 At[4][2], B0[2][2], B1[2][2];
    const char* cA = (const char*)g.A + (size_t)cur.pm * tstepA; const char* cB = (const char*)g.Bt + (size_t)cur.pn * bstep;
    S.a_ready(cur);
    if constexpr (SP2) {
        PG8_STAGE_NT(PG8_SB(0, 0), cB, voffB); PG8_STAGE_NT(PG8_SB(0, 1), cB + bh, voffB); PG8_STAGE(PG8_SA(0, 0), cA, voffA); PG8_STAGE(PG8_SA(0, 1), cA + hstepA, voffA);
        if (wr == 1) PG8_BAR;
        PG8_WAIT_V(2); PG8_BAR;
        PG8_STAGE_NT(PG8_SB(1, 0), cB + kstep, voffB); PG8_STAGE(PG8_SA(1, 0), cA + kstep, voffA); PG8_STAGE_NT(PG8_SB(1, 1), cB + bh + kstep, voffB);
        PG8_WAIT_V(6); PG8_BAR;
    } else {
        PG8_STAGE_NT(PG8_SB(0, 0), cB, voffB); PG8_STAGE(PG8_SA(0, 0), cA, voffA); PG8_STAGE_NT(PG8_SB(0, 1), cB + bh, voffB); PG8_STAGE(PG8_SA(0, 1), cA + hstepA, voffA);
        if (wr == 1) PG8_BAR;
        PG8_WAIT_V(4); PG8_BAR;
        PG8_STAGE_NT(PG8_SB(1, 0), cB + kstep, voffB); PG8_STAGE(PG8_SA(1, 0), cA + kstep, voffA); PG8_STAGE_NT(PG8_SB(1, 1), cB + bh + kstep, voffB);
        PG8_WAIT_V(6); PG8_BAR;
    }
    for (;;) {
        const bool has_next = S.next(ui + 1, nxt);
        const char* nA = has_next ? (const char*)g.A + (size_t)nxt.pm * tstepA : cA; const char* nB = has_next ? (const char*)g.Bt + (size_t)nxt.pn * bstep : cB;
        int t = 0;
        constexpr int NSEG = epi_nseg<Epi>::value;
        if constexpr (epi_state<Epi>::has) E.init(est);
        for (int seg = 0; seg < NSEG; ++seg) {
        int tend = nt; if constexpr (epi_state<Epi>::has) { tend = E.seg_end(seg); E.seg_open(seg, est, cur, wr, wc, fr, fq); }
#pragma nounroll
        for (; t < tend; t += 2) {
            const bool last = (t == nt - 2);
            const char* a1 = cA + (size_t)(t + 1) * kstep;
            const char* a2 = last ? nA : cA + (size_t)(t + 2) * kstep; const char* b2 = last ? nB : cB + (size_t)(t + 2) * kstep;
            const char* a3 = a2 + kstep; const char* b3 = b2 + kstep;
            if constexpr (!epi_late<Epi>::value) { if (last && has_next) S.a_ready(nxt); }
            if constexpr (SP2) {
            PG8_LDB(B0, 0, 0); if constexpr (!NHALF) PG8_LDB(B1, 0, 1); PG8_SCHED; PG8_LDA(At, 0, 0); PG8_STAGE(PG8_SA(1, 1), a1 + hstepA, voffA);
            PG8_WAIT_V(8); PG8_WAIT_L(0); PG8_BAR; PG8_MMA(0, 0, At, B0); if constexpr (!NHALF) PG8_MMA(0, 1, At, B1); PG8_BAR; PG8_SCHED;
            PG8_LDA(At, 0, 1); PG8_STAGE_NT(PG8_SB(0, 0), b2, voffB); PG8_STAGE_NT(PG8_SB(0, 1), b2 + bh, voffB); PG8_STAGE(PG8_SA(0, 0), a2, voffA);
            PG8_WAIT_V(8); PG8_WAIT_L(0); PG8_BAR; PG8_MMA(1, 0, At, B0); if constexpr (!NHALF) PG8_MMA(1, 1, At, B1); PG8_BAR; PG8_SCHED;
            PG8_LDB(B0, 1, 0); if constexpr (!NHALF) PG8_LDB(B1, 1, 1); PG8_SCHED; PG8_LDA(At, 1, 0); PG8_STAGE(PG8_SA(0, 1), a2 + hstepA, voffA);
            PG8_WAIT_V(8); PG8_WAIT_L(0); PG8_BAR; PG8_MMA(0, 0, At, B0); if constexpr (!NHALF) PG8_MMA(0, 1, At, B1); PG8_BAR; PG8_SCHED;
            PG8_LDA(At, 1, 1); PG8_STAGE_NT(PG8_SB(1, 0), b3, voffB); PG8_STAGE_NT(PG8_SB(1, 1), b3 + bh, voffB); PG8_STAGE(PG8_SA(1, 0), a3, voffA);
            PG8_WAIT_V(8); PG8_WAIT_L(0); PG8_BAR; PG8_MMA(1, 0, At, B0); if constexpr (!NHALF) PG8_MMA(1, 1, At, B1); PG8_BAR; PG8_SCHED;
            } else {
            PG8_LDB(B0, 0, 0); PG8_SCHED; PG8_LDA(At, 0, 0); PG8_STAGE(PG8_SA(1, 1), a1 + hstepA, voffA);
            PG8_WAIT_L(8); PG8_BAR; PG8_WAIT_L(0); PG8_MMA(0, 0, At, B0); PG8_BAR; PG8_SCHED;
            PG8_LDB(B1, 0, 1); PG8_STAGE_NT(PG8_SB(0, 0), b2, voffB);
            PG8_BAR; PG8_WAIT_L(0); PG8_MMA(0, 1, At, B1); PG8_BAR;
            PG8_LDA(At, 0, 1); PG8_STAGE(PG8_SA(0, 0), a2, voffA);
            PG8_BAR; PG8_WAIT_L(0); PG8_MMA(1, 0, At, B0); PG8_BAR; PG8_SCHED;
            PG8_STAGE_NT(PG8_SB(0, 1), b2 + bh, voffB);
            PG8_WAIT_V(6); PG8_BAR; PG8_MMA(1, 1, At, B1); PG8_BAR;
            PG8_LDB(B0, 1, 0); PG8_SCHED; PG8_LDA(At, 1, 0); PG8_STAGE(PG8_SA(0, 1), a2 + hstepA, voffA);
            PG8_WAIT_L(8); PG8_BAR; PG8_WAIT_L(0); PG8_MMA(0, 0, At, B0); PG8_BAR; PG8_SCHED;
            PG8_LDB(B1, 1, 1); PG8_STAGE_NT(PG8_SB(1, 0), b3, voffB);
            PG8_BAR; PG8_WAIT_L(0); PG8_MMA(0, 1, At, B1); PG8_BAR;
            PG8_LDA(At, 1, 1); PG8_STAGE(PG8_SA(1, 0), a3, voffA);
            PG8_BAR; PG8_WAIT_L(0); PG8_MMA(1, 0, At, B0); PG8_BAR; PG8_SCHED;
            PG8_STAGE_NT(PG8_SB(1, 1), b3 + bh, voffB);
            PG8_WAIT_V(6); PG8_BAR; PG8_MMA(1, 1, At, B1); PG8_BAR;
            }
        }
        if constexpr (epi_state<Epi>::has) E.seg_close(seg, acc, est);
        }
        if constexpr (ALIGN_EPI) { if (wr == 0) PG8_BAR; }
        if constexpr (epi_late<Epi>::value) { if (has_next) { S.a_ready(nxt); PG8_SCHED; } }
        if constexpr (!Epi::AFTER_DRAIN) { if constexpr (epi_state<Epi>::has) E.finish(acc, est, cur, wr, wc, fr, fq); else E(acc, cur, wr, wc, fr, fq); S.done(cur); }
        if (!has_next) break;
#pragma unroll
        for (int a = 0; a < 2; ++a)
#pragma unroll
            for (int b = 0; b < 2; ++b)
#pragma unroll
                for (int m = 0; m < 4; ++m)
#pragma unroll
                    for (int n = 0; n < 2; ++n) acc[a][b][m][n] = (f32x4){0.f, 0.f, 0.f, 0.f};
        cur = nxt; cA = nA; cB = nB; ++ui;
        if constexpr (ALIGN_EPI) { if (wr == 1) PG8_BAR; }
    }
    PG8_WAIT_V(0);
    if constexpr (!ALIGN_EPI) { if (wr == 0) PG8_BAR; }
    PG8_BAR;
    if constexpr (Epi::AFTER_DRAIN) { E.fused(acc, cur, wr, wc, fr, fq, lds, wid, lane); S.done(cur); }
#undef PG8_SA
#undef PG8_SB
#undef PG8_STAGE
#undef PG8_STAGE_NT
#undef PG8_LDA
#undef PG8_LDB
#undef PG8_MMA
#undef PG8_WAIT_V
#undef PG8_WAIT_L
#undef PG8_BAR
#undef PG8_SCHED
}
}

constexpr int NB = 8, SEQ = 8192, DM = 1024, NCTX = 256, DEPTH = 2;
constexpr int MLAT = NB * SEQ, MCTX = NB * NCTX, MTOT = MLAT + MCTX;
constexpr int NIN = 5376;
constexpr int ZP = 1792;
constexpr int DFF = 2816, NUP = 2 * DFF;
constexpr int S5T = 32, NCH5 = MTOT / S5T, NCH5P = 2304, A2P = 768;
constexpr int NCHM = MTOT / 64;
constexpr int MH1 = 32768;
constexpr float NORM_EPS = 1e-6f;

constexpr size_t al256(size_t x) { return (x + 255) & ~(size_t)255; }
constexpr size_t WS_CTL = 0, CTL_BYTES = 1u << 20;
constexpr size_t WS_SSQ  = WS_CTL + CTL_BYTES;
constexpr size_t ZERO_BYTES = 65536;
constexpr size_t WS_MODP = WS_SSQ + al256((size_t)4 * MTOT * 4);
constexpr size_t WS_MODV = WS_MODP + al256((size_t)2 * 16 * 9 * 6144 * 4);
constexpr size_t WS_ROPE = WS_MODV + al256((size_t)2 * 9 * 6144 * 4);
constexpr size_t WS_LP   = WS_ROPE + al256((size_t)128 * 16 * 2 * 4);
constexpr size_t WS_BB   = WS_LP + al256((size_t)2 * 2 * 16 * 64 * 33 * 2 * 4);
constexpr size_t WS_KD   = WS_BB + al256((size_t)2 * 2 * 16 * 64 * 16 * 2 * 4);
constexpr size_t WS_GAM  = WS_KD + al256((size_t)2 * 16 * 2 * 32 * 256 * 4);
constexpr size_t WS_SHWI = WS_GAM + al256((size_t)2 * 2 * 9 * 1024 * 4);
constexpr size_t WS_SHWU = WS_SHWI + al256((size_t)2 * 9 * NIN * 4);
constexpr size_t WS_WIN  = WS_SHWU + al256((size_t)2 * 9 * NUP * 4);
constexpr size_t WS_WBA  = WS_WIN + (size_t)2 * NIN * 1024 * 2;
constexpr size_t WS_WBS  = WS_WBA + (size_t)2 * 1024 * 512 * 2;
constexpr size_t WS_WBM  = WS_WBS + (size_t)2 * 1024 * 256 * 2;
constexpr size_t WS_WOUT = WS_WBM + (size_t)2 * 1024 * 256 * 2;
constexpr size_t WS_WUP  = WS_WOUT + (size_t)2 * 1024 * 1024 * 2;
constexpr size_t WS_WDN  = WS_WUP + (size_t)2 * NUP * 1024 * 2;
constexpr size_t WS_WGLU = WS_WDN + (size_t)2 * 1024 * DFF * 2;
constexpr size_t WS_W1   = WS_WGLU + (size_t)2 * 256 * 256 * 2;
constexpr size_t WS_W2   = WS_W1 + (size_t)2 * 16 * 256 * 512 * 2;
constexpr size_t WS_XC   = WS_W2 + (size_t)2 * 16 * 512 * 768 * 2;
constexpr size_t WS_HN   = WS_XC + (size_t)MCTX * DM * 4;
constexpr size_t WS_R    = WS_HN + (size_t)MTOT * DM * 2;
constexpr size_t WS_Z1   = WS_R;
constexpr size_t WS_A2   = WS_Z1 + (size_t)MTOT * ZP * 2;
constexpr size_t WS_GM   = WS_A2 + (size_t)16 * NCH5P * A2P * 2;
constexpr size_t WS_GATE = WS_GM + (size_t)MTOT * 16 * 4;
constexpr size_t WS_YS   = WS_GATE + (size_t)MTOT * 3072;
constexpr size_t WS_YPRE = WS_YS + (size_t)MTOT * 256 * 2;
constexpr size_t WS_E    = WS_YPRE + (size_t)MTOT * 256 * 2;
constexpr size_t WS_DC   = WS_E + (size_t)16 * NCH5P * 256 * 4;
constexpr size_t WS_CIN  = WS_DC + (size_t)NCHM * 8 * 4096 * 2;
constexpr size_t WS_DN   = WS_CIN + (size_t)NCHM * 8 * 4096 * 2;
constexpr size_t WS_NIN  = WS_DN + (size_t)NCHM * 8 * 64 * 4;
constexpr size_t WS_BEND = WS_NIN + (size_t)NCHM * 8 * 64 * 4;
constexpr size_t WS_REND = WS_BEND + al256((size_t)NCHM * 8 * 4);
constexpr size_t WS_ACT  = WS_R;
constexpr size_t WS_RAW  = WS_ACT + (size_t)MTOT * DFF * 2;
constexpr size_t WS_FEND = WS_RAW + (size_t)(MTOT / 256) * 4 * NUP * 4;
constexpr size_t WS_HN2  = WS_FEND;
static_assert(WS_HN2 + (size_t)MTOT * DM * 2 <= WS_REND, "HN2 placement");
constexpr size_t WS_END  = WS_REND > WS_FEND ? WS_REND : WS_FEND;
static_assert(WS_END <= ((size_t)1 << 30), "d_ws map exceeds 1 GiB");
static_assert(WS_Z1 % 256 == 0 && WS_A2 % 256 == 0 && WS_HN % 256 == 0 && WS_E % 256 == 0 && WS_DC % 256 == 0 && WS_RAW % 256 == 0 && WS_HN2 % 256 == 0 && WS_WIN % 256 == 0, "alignment");

constexpr int CW_BAR = 4096;

constexpr int RING_BYTES = 131072, MISC_OFF = RING_BYTES + 320, PREF_OFF = RING_BYTES + 10240, LDS_BYTES = 147456;

#define LAS __attribute__((address_space(3)))
typedef unsigned short bf16;
typedef short bf16x8 __attribute__((ext_vector_type(8)));
typedef short s16x4 __attribute__((ext_vector_type(4)));
typedef float f32x4 __attribute__((ext_vector_type(4)));
typedef float f32x16 __attribute__((ext_vector_type(16)));
typedef float f32x8 __attribute__((ext_vector_type(8)));
typedef unsigned u32x4 __attribute__((ext_vector_type(4)));
typedef unsigned u32x2 __attribute__((ext_vector_type(2)));

typedef float f32x2_t __attribute__((ext_vector_type(2))); typedef __bf16 bf16x2_t __attribute__((ext_vector_type(2)));
__device__ __forceinline__ unsigned pk2(float lo, float hi) { f32x2_t v = {lo, hi}; bf16x2_t b = __builtin_convertvector(v, bf16x2_t); return __builtin_bit_cast(unsigned, b); }
__device__ __forceinline__ float bflo(unsigned w) { return __uint_as_float(w << 16); }
__device__ __forceinline__ float bfhi(unsigned w) { return __uint_as_float(w & 0xffff0000u); }
__device__ __forceinline__ float bf2f(bf16 h) { return __uint_as_float(((unsigned)h) << 16); }
__device__ __forceinline__ bf16 f2bf(float f) { return (bf16)(pk2(f, 0.f) & 0xffffu); }
__device__ __forceinline__ float sigmoidf_(float x) { return __builtin_amdgcn_rcpf(1.0f + __expf(-x)); }
__device__ __forceinline__ float wave_sum(float v) {
#pragma unroll
    for (int o = 1; o < 64; o <<= 1) v += __shfl_xor(v, o);
    return v;
}

#define XB_TMO      128
#define XB_XCNT(j)  (256  + 64 * (j))
#define XB_XSUB(j)  (1280 + 64 * (j))
#define XB_XGEN(j)  (2304 + 64 * (j))
#define XB_TOP      3328
#define XB_TOPGEN   3392
#define XCD_BAR_WORDS 3456
#define XB_SPIN_CAP (1u << 18)
__device__ __forceinline__ unsigned xb_ld(unsigned* p)              { return __hip_atomic_load(p, __ATOMIC_RELAXED, __HIP_MEMORY_SCOPE_AGENT); }
__device__ __forceinline__ unsigned xb_add(unsigned* p, unsigned v) { return __hip_atomic_fetch_add(p, v, __ATOMIC_RELAXED, __HIP_MEMORY_SCOPE_AGENT); }
__device__ __forceinline__ unsigned xb_xcc_id() { return (unsigned)__builtin_amdgcn_s_getreg((3 << 11) | 20) & 0xFu; }
#define XB_SPIN(cond, bar) do { unsigned _sp = 0; while (cond) { __builtin_amdgcn_s_sleep(1); \
    if ((++_sp & 255u) == 0u) { if (xb_ld(&(bar)[XB_TMO])) break; if (_sp > XB_SPIN_CAP) { atomicAdd(&(bar)[XB_TMO], 1u); break; } } } } while (0)
struct XcdBarrier { unsigned* bar; unsigned x; volatile LAS unsigned* st; };
__device__ __forceinline__ XcdBarrier xcd_barrier_post(unsigned* bar, volatile LAS unsigned* st) {
    XcdBarrier b; b.bar = bar; b.x = xb_xcc_id(); b.st = st;
    if (threadIdx.x == 0) (void)xb_add(&bar[XB_XCNT(b.x)], 1u);
    return b;
}
__device__ __forceinline__ void xcd_barrier_complete(unsigned* bar, unsigned x, unsigned& nloc, unsigned& nx) {
    const unsigned G = gridDim.x * gridDim.y * gridDim.z;
    unsigned sum, cnt, mine, sp = 0u;
    for (;;) {
        sum = 0u; cnt = 0u; mine = 0u;
#pragma unroll
        for (unsigned j = 0; j < 16; ++j) { const unsigned c = xb_ld(&bar[XB_XCNT(j)]); sum += c; cnt += (c > 0u) ? 1u : 0u; mine = (j == x) ? c : mine; }
        if (sum == G) break;
        __builtin_amdgcn_s_sleep(1);
        if ((++sp & 255u) == 0u) { if (xb_ld(&bar[XB_TMO])) break; if (sp > XB_SPIN_CAP) { atomicAdd(&bar[XB_TMO], 1u); break; } }
    }
    nloc = mine > 0u ? mine : 1u; nx = cnt > 0u ? cnt : 1u;
}
__device__ __forceinline__ void xcd_barrier(const XcdBarrier& b) {
    asm volatile("s_waitcnt vmcnt(0)" ::: "memory");
    __syncthreads();
    if (threadIdx.x == 0) {
        unsigned* bar = b.bar;
        __builtin_amdgcn_s_waitcnt(0);
        unsigned nloc = b.st[0], nx = b.st[1];
        if (nloc == 0u) { xcd_barrier_complete(bar, b.x, nloc, nx); b.st[0] = nloc; b.st[1] = nx; }
        const unsigned old = xb_add(&bar[XB_XSUB(b.x)], 1u);
        const unsigned gen = old / nloc;
        if (old + 1u == (gen + 1u) * nloc) {
            __builtin_amdgcn_fence(__ATOMIC_RELEASE, "agent");
            asm volatile("s_waitcnt vmcnt(0)" ::: "memory");
            const unsigned og = xb_add(&bar[XB_TOP], 1u);
            const unsigned tg = og / nx;
            if (og + 1u == (tg + 1u) * nx) xb_add(&bar[XB_TOPGEN], 1u);
            else XB_SPIN(xb_ld(&bar[XB_TOPGEN]) == tg, bar);
            __builtin_amdgcn_fence(__ATOMIC_ACQUIRE, "agent");
            xb_add(&bar[XB_XGEN(b.x)], 1u);
            asm volatile("s_waitcnt vmcnt(0)" ::: "memory");
        } else {
            XB_SPIN(xb_ld(&bar[XB_XGEN(b.x)]) == gen, bar);
            __builtin_amdgcn_fence(__ATOMIC_ACQUIRE, "agent");
            asm volatile("s_waitcnt vmcnt(0)" ::: "memory");
        }
    }
    __syncthreads();
}

struct GroupOrder {
    int ng, mt, nt, G, c, mstride;
    __device__ __forceinline__ bool next(int i, pg8::Unit& u) const {
        const long L = (long)i * G + c; const int per = mt * nt; if (L >= (long)ng * per) return false;
        const int l = (int)L, g = l / per, r = l % per; u.pm = g * mstride + r / nt; u.pn = g * nt + r % nt; u.seq = i; return true;
    }
    __device__ __forceinline__ void a_ready(const pg8::Unit&) const {}
    __device__ __forceinline__ void done(const pg8::Unit&) const {}
};

struct RoundOrder {
    pg8::StaticOrder b; int r;
    __device__ __forceinline__ bool next(int i, pg8::Unit& u) const { return i == 0 && b.next(r, u); }
    __device__ __forceinline__ void a_ready(const pg8::Unit&) const {}
    __device__ __forceinline__ void done(const pg8::Unit&) const {}
};
struct PrefOrder : pg8::StaticOrder {
    const float* ssq; const float* shw; int ldsh; LAS float* slot;
    __device__ __forceinline__ void a_ready(const pg8::Unit& u) const {
        const int w = __builtin_amdgcn_readfirstlane(threadIdx.x >> 6), lane = threadIdx.x & 63;
        if (w < 2) { const int grow0 = u.pm * 256; const int jb = grow0 < MLAT ? (grow0 >> 13) : 8;
            const float* src = w == 0 ? ssq + grow0 + 4 * lane : shw + (size_t)jb * ldsh + u.pn * 256 + 4 * lane;
            LAS float* dst = slot + (u.seq & 1) * 512 + w * 256;
            __builtin_amdgcn_global_load_lds((const unsigned*)src, (LAS unsigned*)dst, 16, 0, 0); }
    }
};
__device__ __forceinline__ float logsig(float x) { return x >= 0.f ? -log1pf(expf(-x)) : x - log1pf(expf(x)); }
struct EpiWin {
    static constexpr bool PERM = true, AFTER_DRAIN = false, LATE_READY = true;
    bf16* z1; bf16* a2; float* gm; unsigned char* gate; const LAS float* slot  ; const float* igb; const float* fgb;
    __device__ __forceinline__ void operator()(const f32x4 (&acc)[2][2][4][2], const pg8::Unit& u, int wr, int wc, int fr, int fq) const {
        const int pn = u.pn; const int row0 = u.pm * 256 + wr * 64 + fr;
        const LAS float* sl = slot + (u.seq & 1) * 512;
        f32x4 sw[2][2];
#pragma unroll
        for (int bj = 0; bj < 2; ++bj) { const LAS float* sp = sl + 256 + bj * 128 + wc * 32 + fq * 8; sw[bj][0] = *(const LAS f32x4*)sp; sw[bj][1] = *(const LAS f32x4*)(sp + 4); }
        float rsv[2][4];
#pragma unroll
        for (int ai = 0; ai < 2; ++ai)
#pragma unroll
            for (int m = 0; m < 4; ++m) rsv[ai][m] = sl[wr * 64 + fr + ai * 128 + m * 16];
#pragma unroll
        for (int ai = 0; ai < 2; ++ai)
#pragma unroll
            for (int m = 0; m < 4; ++m) rsv[ai][m] = rsqrtf(rsv[ai][m] * (1.0f / DM) + NORM_EPS);
        if (pn >= 9) {
#pragma unroll
            for (int ai = 0; ai < 2; ++ai)
#pragma unroll
                for (int m = 0; m < 4; ++m) rsv[ai][m] *= -1.4426950408889634f;
#pragma unroll
            for (int bj = 0; bj < 2; ++bj) { sw[bj][0] = sw[bj][0] * -1.4426950408889634f; sw[bj][1] = sw[bj][1] * -1.4426950408889634f; } }
#pragma unroll
        for (int ai = 0; ai < 2; ++ai)
#pragma unroll
            for (int m = 0; m < 4; ++m) { const int row = row0 + ai * 128 + m * 16;
                const float rs = rsv[ai][m];
#pragma unroll
                for (int bj = 0; bj < 2; ++bj) { const int cl = bj * 128 + wc * 32 + fq * 8; f32x4 v0 = acc[ai][bj][m][0] * rs + sw[bj][0], v1 = acc[ai][bj][m][1] * rs + sw[bj][1];
                    if (pn >= 9) {
                        u32x2 w; w.x = 0u; w.y = 0u;
#pragma unroll
                        for (int e = 0; e < 4; ++e) {
                            w.x = __builtin_amdgcn_cvt_pk_u8_f32(__builtin_floorf(__builtin_amdgcn_rcpf(1.0f + __builtin_amdgcn_exp2f(v0[e])) * 255.0f + 0.5f), e, w.x);
                            w.y = __builtin_amdgcn_cvt_pk_u8_f32(__builtin_floorf(__builtin_amdgcn_rcpf(1.0f + __builtin_amdgcn_exp2f(v1[e])) * 255.0f + 0.5f), e, w.y); }
                        *(u32x2*)(gate + (size_t)row * 3072 + (pn - 9) * 256 + cl) = w;
                    } else if (pn == 8) {
                        if (cl < 16) { float* d = gm + (size_t)row * 16 + cl;
                            const f32x4 bi = *(const f32x4*)(igb + (cl >> 3) * 4), bf = *(const f32x4*)(fgb + (cl >> 3) * 4); v0 = v0 + bi;
#pragma unroll
                            for (int e = 0; e < 4; ++e) v1[e] = logsig(v1[e] + bf[e]);
                            *(f32x4*)d = v0; *(f32x4*)(d + 4) = v1; }
                    } else {
                        if (pn == 5) { v0 = v0 * 0.125f; v1 = v1 * 0.125f; }
                        if (pn < 2) { v0 = v0 * 0.18033688011112042f; v1 = v1 * 0.18033688011112042f; }
                        u32x4 w; w.x = pk2(v0[0], v0[1]); w.y = pk2(v0[2], v0[3]); w.z = pk2(v1[0], v1[1]); w.w = pk2(v1[2], v1[3]);
                        if (pn == 3) { const int g = cl >> 4, cc = cl & 15; *(u32x4*)(a2 + ((size_t)g * NCH5P + (row >> 5)) * A2P + (row & 31) * 16 + cc) = w; }
                        else { const int col = (pn < 3 ? pn * 256 : 768 + (pn - 4) * 256) + cl; *(u32x4*)(z1 + (size_t)row * ZP + col) = w; }
                    }
                } }
    }
};
struct EpiS5E {
    static constexpr bool PERM = false, AFTER_DRAIN = false;
    float* E;
    __device__ __forceinline__ void operator()(const f32x4 (&acc)[2][2][4][2], const pg8::Unit& u, int wr, int wc, int fr, int fq) const {
        const int row0 = u.pm * 256 + wr * 64 + fr;
#pragma unroll
        for (int ai = 0; ai < 2; ++ai)
#pragma unroll
            for (int m = 0; m < 4; ++m) { const int row = row0 + ai * 128 + m * 16; if ((row % NCH5P) >= NCH5) continue;
#pragma unroll
                for (int bj = 0; bj < 2; ++bj)
#pragma unroll
                    for (int n = 0; n < 2; ++n) *(f32x4*)(E + (size_t)row * 256 + bj * 128 + wc * 32 + n * 16 + fq * 4) = acc[ai][bj][m][n]; }
    }
};
__device__ __forceinline__ float gelu_tanh(float x) { const float u = 0.7978845608028654f * (x + 0.044715f * x * x * x); const float e = __expf(2.0f * u); const float th = 1.0f - 2.0f / (e + 1.0f); return 0.5f * x * (1.0f + th); }
struct EpiS5Y {
    static constexpr bool PERM = true, AFTER_DRAIN = false;
    bf16* ypre;
    __device__ __forceinline__ void operator()(const f32x4 (&acc)[2][2][4][2], const pg8::Unit& u, int wr, int wc, int fr, int fq) const {
        const int g = u.pm / 9, jn = u.pn & 1; const int ch0 = (u.pm % 9) * 256 + wr * 64 + fr;
#pragma unroll
        for (int ai = 0; ai < 2; ++ai)
#pragma unroll
            for (int m = 0; m < 4; ++m) { const int ch = ch0 + ai * 128 + m * 16; if (ch >= NCH5) continue;
#pragma unroll
                for (int bj = 0; bj < 2; ++bj) { const int nl = jn * 256 + bj * 128 + wc * 32 + fq * 8; const int t = nl >> 4, c = nl & 15; const f32x4 v0 = acc[ai][bj][m][0], v1 = acc[ai][bj][m][1];
                    u32x4 w; w.x = pk2(gelu_tanh(v0[0]), gelu_tanh(v0[1])); w.y = pk2(gelu_tanh(v0[2]), gelu_tanh(v0[3])); w.z = pk2(gelu_tanh(v1[0]), gelu_tanh(v1[1])); w.w = pk2(gelu_tanh(v1[2]), gelu_tanh(v1[3]));
                    *(u32x4*)(ypre + ((size_t)ch * 32 + t) * 256 + g * 16 + c) = w; } asm volatile("" ::: "memory"); }
    }
};
struct EpiGlu {
    static constexpr bool PERM = true, AFTER_DRAIN = false;
    const bf16* ypre; bf16* ys; const float* bias; int ldy;
    __device__ __forceinline__ void operator()(const f32x4 (&acc)[2][2][4][2], const pg8::Unit& u, int wr, int wc, int fr, int fq) const {
        const int row0 = u.pm * 256 + wr * 64 + fr; const int colb = wc * 32 + fq * 8;
        f32x4 bs[2][2];
#pragma unroll
        for (int bj = 0; bj < 2; ++bj) { bs[bj][0] = *(const f32x4*)(bias + bj * 128 + colb); bs[bj][1] = *(const f32x4*)(bias + bj * 128 + colb + 4); }
#pragma unroll
        for (int ai = 0; ai < 2; ++ai) {
            u32x4 yv[4][2];
#pragma unroll
            for (int m = 0; m < 4; ++m)
#pragma unroll
                for (int bj = 0; bj < 2; ++bj) yv[m][bj] = *(const u32x4*)(ypre + (size_t)(row0 + ai * 128 + m * 16) * 256 + bj * 128 + colb);
#pragma unroll
            for (int m = 0; m < 4; ++m)
#pragma unroll
                for (int bj = 0; bj < 2; ++bj) { const f32x4 v0 = acc[ai][bj][m][0] + bs[bj][0], v1 = acc[ai][bj][m][1] + bs[bj][1]; const u32x4 y = yv[m][bj];
                    u32x4 w;
                    w.x = pk2(bflo(y.x) * sigmoidf_(v0[0]), bfhi(y.x) * sigmoidf_(v0[1])); w.y = pk2(bflo(y.y) * sigmoidf_(v0[2]), bfhi(y.y) * sigmoidf_(v0[3]));
                    w.z = pk2(bflo(y.z) * sigmoidf_(v1[0]), bfhi(y.z) * sigmoidf_(v1[1])); w.w = pk2(bflo(y.w) * sigmoidf_(v1[2]), bfhi(y.w) * sigmoidf_(v1[3]));
                    *(u32x4*)(ys + (size_t)(row0 + ai * 128 + m * 16) * ldy + bj * 128 + colb) = w; }
            asm volatile("" ::: "memory");
        }
    }
};
struct EpiMergeF {
    static constexpr bool PERM = true, AFTER_DRAIN = false;
    struct State { f32x4 Y[2][4][2]; u32x2 gq[2][4]; };
    bf16* y; const unsigned char* gate;
    __device__ __forceinline__ void fetch(State& st, const pg8::Unit& u, int wr, int wc, int fr, int fq, int goff) const {
        const unsigned char* gp = gate + (size_t)(u.pm * 256 + wr * 64 + fr) * 3072 + goff + u.pn * 128 + wc * 32 + fq * 8;
#pragma unroll
        for (int ai = 0; ai < 2; ++ai)
#pragma unroll
            for (int m = 0; m < 4; ++m) st.gq[ai][m] = *(const u32x2*)(gp + (size_t)(ai * 128 + m * 16) * 3072);
    }
    __device__ __forceinline__ void close(f32x4 (&acc)[2][2][4][2], State& st) const {
        const float s = 1.0f / 255.0f;
#pragma unroll
        for (int ai = 0; ai < 2; ++ai)
#pragma unroll
            for (int m = 0; m < 4; ++m) { const u32x2 g = st.gq[ai][m];
                const f32x4 g0 = {(float)(g.x & 255u) * s, (float)((g.x >> 8) & 255u) * s, (float)((g.x >> 16) & 255u) * s, (float)(g.x >> 24) * s};
                const f32x4 g1 = {(float)(g.y & 255u) * s, (float)((g.y >> 8) & 255u) * s, (float)((g.y >> 16) & 255u) * s, (float)(g.y >> 24) * s};
                st.Y[ai][m][0] += g0 * acc[ai][0][m][0]; st.Y[ai][m][1] += g1 * acc[ai][0][m][1];
                acc[ai][0][m][0] = (f32x4){0.f, 0.f, 0.f, 0.f}; acc[ai][0][m][1] = (f32x4){0.f, 0.f, 0.f, 0.f}; }
    }
    static constexpr int NSEG = 3;
    __device__ __forceinline__ int seg_end(int seg) const { return seg == 0 ? 8 : (seg == 1 ? 12 : 16); }
    __device__ __forceinline__ void init(State& st) const {
#pragma unroll
        for (int ai = 0; ai < 2; ++ai)
#pragma unroll
            for (int m = 0; m < 4; ++m) { st.Y[ai][m][0] = (f32x4){0.f, 0.f, 0.f, 0.f}; st.Y[ai][m][1] = (f32x4){0.f, 0.f, 0.f, 0.f}; st.gq[ai][m] = (u32x2){0u, 0u}; }
    }
    __device__ __forceinline__ void seg_open(int seg, State& st, const pg8::Unit& u, int wr, int wc, int fr, int fq) const { fetch(st, u, wr, wc, fr, fq, seg * 1024); }
    __device__ __forceinline__ void seg_close(int seg, f32x4 (&acc)[2][2][4][2], State& st) const { close(acc, st); }
    __device__ __forceinline__ void finish(f32x4 (&acc)[2][2][4][2], State& st, const pg8::Unit& u, int wr, int wc, int fr, int fq) const {
        bf16* yp = y + (size_t)(u.pm * 256 + wr * 64 + fr) * 1024 + u.pn * 128 + wc * 32 + fq * 8;
#pragma unroll
        for (int ai = 0; ai < 2; ++ai)
#pragma unroll
            for (int m = 0; m < 4; ++m) { const f32x4 a = st.Y[ai][m][0], b = st.Y[ai][m][1]; u32x4 w; w.x = pk2(a[0], a[1]); w.y = pk2(a[2], a[3]); w.z = pk2(b[0], b[1]); w.w = pk2(b[2], b[3]);
                *(u32x4*)(yp + (size_t)(ai * 128 + m * 16) * 1024) = w; }
    }
};
template <bool FIRST> struct EpiMerge {
    static constexpr bool PERM = true, AFTER_DRAIN = false;
    bf16* y; const unsigned char* gate; int goff;
    __device__ __forceinline__ void operator()(const f32x4 (&acc)[2][2][4][2], const pg8::Unit& u, int wr, int wc, int fr, int fq) const {
        const int row0 = u.pm * 256 + wr * 64 + fr; const int col0 = u.pn * 256 + wc * 32 + fq * 8; const float s = 1.0f / 255.0f;
#pragma unroll
        for (int ai = 0; ai < 2; ++ai) {
            u32x2 gq[4][2]; u32x4 old[4][2];
#pragma unroll
            for (int m = 0; m < 4; ++m)
#pragma unroll
                for (int bj = 0; bj < 2; ++bj) { const size_t row = (size_t)(row0 + ai * 128 + m * 16); gq[m][bj] = *(const u32x2*)(gate + row * 3072 + goff + col0 + bj * 128);
                    if (!FIRST) old[m][bj] = *(const u32x4*)(y + row * 1024 + col0 + bj * 128); }
#pragma unroll
            for (int m = 0; m < 4; ++m)
#pragma unroll
                for (int bj = 0; bj < 2; ++bj) { const f32x4 v0 = acc[ai][bj][m][0], v1 = acc[ai][bj][m][1]; const u32x2 g = gq[m][bj];
                    float o[8];
                    o[0] = v0[0] * ((float)(g.x & 255u) * s); o[1] = v0[1] * ((float)((g.x >> 8) & 255u) * s); o[2] = v0[2] * ((float)((g.x >> 16) & 255u) * s); o[3] = v0[3] * ((float)(g.x >> 24) * s);
                    o[4] = v1[0] * ((float)(g.y & 255u) * s); o[5] = v1[1] * ((float)((g.y >> 8) & 255u) * s); o[6] = v1[2] * ((float)((g.y >> 16) & 255u) * s); o[7] = v1[3] * ((float)(g.y >> 24) * s);
                    if (!FIRST) { const u32x4 od = old[m][bj]; o[0] += bflo(od.x); o[1] += bfhi(od.x); o[2] += bflo(od.y); o[3] += bfhi(od.y); o[4] += bflo(od.z); o[5] += bfhi(od.z); o[6] += bflo(od.w); o[7] += bfhi(od.w); }
                    u32x4 w; w.x = pk2(o[0], o[1]); w.y = pk2(o[2], o[3]); w.z = pk2(o[4], o[5]); w.w = pk2(o[6], o[7]);
                    *(u32x4*)(y + (size_t)(row0 + ai * 128 + m * 16) * 1024 + col0 + bj * 128) = w; }
            asm volatile("" ::: "memory");
        }
    }
};
template <bool EMIT, bool NH = false> struct EpiResid {
    static constexpr int NBJ = NH ? 1 : 2;
    static constexpr bool PERM = true, AFTER_DRAIN = false;
    const float* xin_lat; const float* xin_ctx; float* xout_lat; float* xout_ctx; const float* gvec  ; int rowbase;
    bf16* hn; const float* gam  ; float* ssq;
    __device__ __forceinline__ void operator()(const f32x4 (&acc)[2][2][4][2], const pg8::Unit& u, int wr, int wc, int fr, int fq) const {
        const int grow0 = rowbase + u.pm * 256; const bool isc = grow0 >= MLAT; const int j = isc ? 8 : (grow0 >> 13);
        const float* xi = isc ? xin_ctx - (size_t)MLAT * DM : xin_lat; float* xo = isc ? xout_ctx - (size_t)MLAT * DM : xout_lat;
        const int row0 = grow0 + wr * 64 + fr; const int colb = u.pn * (NH ? 128 : 256) + wc * 32 + fq * 8;
        f32x4 gg[2][2], gm_[2][2];
#pragma unroll
        for (int bj = 0; bj < NBJ; ++bj) { const float* gp = gvec + (size_t)j * 6144 + colb + bj * 128; gg[bj][0] = *(const f32x4*)gp; gg[bj][1] = *(const f32x4*)(gp + 4);
            if (EMIT) { const float* mp = gam + (size_t)j * 1024 + colb + bj * 128; gm_[bj][0] = *(const f32x4*)mp; gm_[bj][1] = *(const f32x4*)(mp + 4); } }
        f32x4 xv[3][2][2];
        auto loadx = [&](int k, f32x4 (&d)[2][2]) {
#pragma unroll
            for (int bj = 0; bj < NBJ; ++bj) { const float* p = xi + (size_t)(row0 + (k >> 2) * 128 + (k & 3) * 16) * DM + colb + bj * 128; d[bj][0] = *(const f32x4*)p; d[bj][1] = *(const f32x4*)(p + 4); } };
        loadx(0, xv[0]); loadx(1, xv[1]);
#pragma unroll
        for (int k = 0; k < 8; ++k) { const int ai = k >> 2, m = k & 3;
            if (k + 2 < 8) loadx(k + 2, xv[(k + 2) % 3]);
            __builtin_amdgcn_sched_barrier(0);
            const size_t row = (size_t)(row0 + ai * 128 + m * 16); float sq = 0.f;
#pragma unroll
            for (int bj = 0; bj < NBJ; ++bj) { const f32x4 x0 = xv[k % 3][bj][0] + gg[bj][0] * acc[ai][bj][m][0], x1 = xv[k % 3][bj][1] + gg[bj][1] * acc[ai][bj][m][1];
                float* op = xo + row * DM + colb + bj * 128; *(f32x4*)op = x0; *(f32x4*)(op + 4) = x1;
                if (EMIT) { sq += ((x0[0] * x0[0] + x0[1] * x0[1]) + (x0[2] * x0[2] + x0[3] * x0[3])) + ((x1[0] * x1[0] + x1[1] * x1[1]) + (x1[2] * x1[2] + x1[3] * x1[3]));
                    const f32x4 h0 = x0 * gm_[bj][0], h1 = x1 * gm_[bj][1]; u32x4 w; w.x = pk2(h0[0], h0[1]); w.y = pk2(h0[2], h0[3]); w.z = pk2(h1[0], h1[1]); w.w = pk2(h1[2], h1[3]);
                    *(u32x4*)(hn + row * DM + colb + bj * 128) = w; } }
            if (EMIT) { sq += __shfl_xor(sq, 16); sq += __shfl_xor(sq, 32); if (fq == 0) atomicAdd(ssq + row, sq); }
            __builtin_amdgcn_sched_barrier(0);
        }
    }
};
__device__ __forceinline__ float dpp_prev(float self, float up) {
    const int seam = __builtin_amdgcn_mov_dpp(__builtin_bit_cast(int, up), 0x121  , 0xf, 0xf, false);
    return __builtin_bit_cast(float, __builtin_amdgcn_update_dpp(seam, __builtin_bit_cast(int, self), 0x111  , 0xf, 0xf, false)); }
__device__ __forceinline__ float dpp_next(float self, float dn) {
    const int seam = __builtin_amdgcn_mov_dpp(__builtin_bit_cast(int, dn), 0x12F  , 0xf, 0xf, false);
    return __builtin_bit_cast(float, __builtin_amdgcn_update_dpp(seam, __builtin_bit_cast(int, self), 0x101  , 0xf, 0xf, false)); }
struct EpiUpConv {
    static constexpr bool PERM = true, AFTER_DRAIN = false;
    bf16* act; float* raw; const LAS float* slot  ; const float* cw  ; const float* cb  ; LAS float* X  ;
    __device__ __forceinline__ void operator()(f32x4 (&acc)[2][2][4][2], const pg8::Unit& u, int wr, int wc, int fr_, int fq_) const {
        int fr = fr_, fq = fq_; asm volatile("" : "+v"(fr), "+v"(fq));
        const int grow0 = u.pm * 256; const int row0 = grow0 + wr * 64 + fr; const int cl = wc * 32 + fq * 8;
        { f32x4 sw[2][2]; float rsv[2][4]; const LAS float* sl = slot + (u.seq & 1) * 512;
#pragma unroll
          for (int bj = 0; bj < 2; ++bj) { const LAS float* sp = sl + 256 + bj * 128 + cl; sw[bj][0] = *(const LAS f32x4*)sp; sw[bj][1] = *(const LAS f32x4*)(sp + 4); }
#pragma unroll
          for (int ai = 0; ai < 2; ++ai)
#pragma unroll
              for (int m = 0; m < 4; ++m) rsv[ai][m] = sl[wr * 64 + fr + ai * 128 + m * 16];
#pragma unroll
          for (int ai = 0; ai < 2; ++ai)
#pragma unroll
              for (int m = 0; m < 4; ++m) { const float rs = rsqrtf(rsv[ai][m] * (1.0f / DM) + NORM_EPS);
#pragma unroll
                  for (int bj = 0; bj < 2; ++bj)
#pragma unroll
                      for (int n = 0; n < 2; ++n) { acc[ai][bj][m][n] = acc[ai][bj][m][n] * rs + sw[bj][n]; asm volatile("" : "+v"(acc[ai][bj][m][n])); } } }
#pragma unroll
        for (int ai = 0; ai < 2; ++ai) { const int bidx = 2 * ai + wr;
            if (fr == 0) {
#pragma unroll
                for (int bj = 0; bj < 2; ++bj) { LAS float* xp = X + (2 * bidx) * 256 + bj * 128 + cl; *(LAS f32x4*)xp = acc[ai][bj][0][0]; *(LAS f32x4*)(xp + 4) = acc[ai][bj][0][1]; } }
            if (fr == 15) {
#pragma unroll
                for (int bj = 0; bj < 2; ++bj) { LAS float* xp = X + (2 * bidx + 1) * 256 + bj * 128 + cl; *(LAS f32x4*)xp = acc[ai][bj][3][0]; *(LAS f32x4*)(xp + 4) = acc[ai][bj][3][1]; } }
        }
        if (wr == 0 && fr < 2) {
#pragma unroll
            for (int bj = 0; bj < 2; ++bj) { float* rp = raw + ((size_t)u.pm * 4 + fr) * NUP + u.pn * 256 + bj * 128 + cl; *(f32x4*)rp = acc[0][bj][0][0]; *(f32x4*)(rp + 4) = acc[0][bj][0][1]; } }
        if (wr == 1 && fr >= 14) {
#pragma unroll
            for (int bj = 0; bj < 2; ++bj) { float* rp = raw + ((size_t)u.pm * 4 + fr - 12) * NUP + u.pn * 256 + bj * 128 + cl; *(f32x4*)rp = acc[1][bj][3][0]; *(f32x4*)(rp + 4) = acc[1][bj][3][1]; } }
        asm volatile("s_waitcnt lgkmcnt(0)" ::: "memory"); __builtin_amdgcn_s_barrier(); asm volatile("" ::: "memory"); __builtin_amdgcn_sched_barrier(0);
        const int ch = u.pn * 128 + cl;
#pragma unroll
        for (int ai = 0; ai < 2; ++ai) { const int bidx = 2 * ai + wr;
            u32x2 wlo[4];
#pragma unroll
            for (int n = 0; n < 2; ++n) {
                f32x4 ca[4];
#pragma unroll
                for (int bj = 0; bj < 2; ++bj) {
                    const float* wp = cw + bj * DFF + ch + 4 * n;
                    const f32x4 w0 = *(const f32x4*)wp, w1 = *(const f32x4*)(wp + NUP), w2 = *(const f32x4*)(wp + 2 * NUP), bb = *(const f32x4*)(cb + bj * DFF + ch + 4 * n);
                    const f32x4 xp = bidx > 0 ? *(const LAS f32x4*)(X + (2 * bidx - 1) * 256 + bj * 128 + cl + 4 * n) : (f32x4){0.f, 0.f, 0.f, 0.f};
                    const f32x4 xn = bidx < 3 ? *(const LAS f32x4*)(X + (2 * bidx + 2) * 256 + bj * 128 + cl + 4 * n) : (f32x4){0.f, 0.f, 0.f, 0.f};
#pragma unroll
                    for (int m = 0; m < 4; ++m) { const f32x4 self = acc[ai][bj][m][n]; const f32x4 us = m == 0 ? xp : acc[ai][bj][m == 0 ? 0 : m - 1][n]; const f32x4 ds = m == 3 ? xn : acc[ai][bj][m == 3 ? 3 : m + 1][n]; f32x4 o;
#pragma unroll
                        for (int e = 0; e < 4; ++e) { const float pv = dpp_prev(self[e], us[e]); const float nx = dpp_next(self[e], ds[e]); o[e] = bb[e] + w0[e] * pv + w1[e] * self[e] + w2[e] * nx; }
                        asm volatile("" : "+v"(o));
                        if (bj == 0) ca[m] = o;
                        else { const bool skip = (bidx == 0 && m == 0 && fr == 0) || (bidx == 3 && m == 3 && fr == 15);
                            u32x2 w; w.x = pk2(ca[m][0] * sigmoidf_(ca[m][0]) * o[0], ca[m][1] * sigmoidf_(ca[m][1]) * o[1]); w.y = pk2(ca[m][2] * sigmoidf_(ca[m][2]) * o[2], ca[m][3] * sigmoidf_(ca[m][3]) * o[3]);
                            if (n == 0) wlo[m] = w;
                            else if (!skip) { u32x4 w4; w4.x = wlo[m].x; w4.y = wlo[m].y; w4.z = w.x; w4.w = w.y; *(u32x4*)(act + (size_t)(row0 + ai * 128 + m * 16) * DFF + ch) = w4; } }
                        __builtin_amdgcn_sched_barrier(0); }
                    asm volatile("" ::: "memory");
                }
            }
        }
    }
};
struct EpiPlain {
    static constexpr bool PERM = true, AFTER_DRAIN = false;
    bf16* O; int ldc;
    __device__ __forceinline__ void operator()(const f32x4 (&acc)[2][2][4][2], const pg8::Unit& u, int wr, int wc, int fr, int fq) const {
        const int row0 = u.pm * 256 + wr * 64 + fr;
#pragma unroll
        for (int ai = 0; ai < 2; ++ai)
#pragma unroll
            for (int m = 0; m < 4; ++m) { bf16* rp = O + (size_t)(row0 + ai * 128 + m * 16) * ldc + u.pn * 256 + wc * 32 + fq * 8;
#pragma unroll
                for (int bj = 0; bj < 2; ++bj) { const f32x4 v0 = acc[ai][bj][m][0], v1 = acc[ai][bj][m][1]; u32x4 w; w.x = pk2(v0[0], v0[1]); w.y = pk2(v0[2], v0[3]); w.z = pk2(v1[0], v1[1]); w.w = pk2(v1[2], v1[3]); *(u32x4*)(rp + bj * 128) = w; } }
    }
};

struct Args { const float* in[32]; float* out; unsigned char* ws; int ph_lo, ph_hi; };

typedef const __attribute__((address_space(4))) Args* KArgP;
__device__ __forceinline__ KArgP kargs() { KArgP p = (KArgP)__builtin_amdgcn_kernarg_segment_ptr(); asm volatile("" : "+s"(p)); return p; }
constexpr int GRID = 256;
struct Ctx {
    LAS unsigned char* lds; int tid, lane, wave, G, bid;
    KArgP ap;
};
__device__ __forceinline__ bool phase_enter(Ctx& C) { C.ap = kargs(); asm volatile("" : "+v"(C.tid), "+v"(C.lane)); return true; }
#define WSP(T, off) ((T*)(C.ap->ws + (off)))
#define INP(i) (C.ap->in[i])
#define OUTP (C.ap->out)

__device__ __forceinline__ void sincos_d(double th, double& s, double& c) {
    const double TWO_PI = 6.283185307179586476925287;
    const double n = rint(th / TWO_PI); const double r = (th - n * 6.28318530717958623200) - n * 2.4492935982947064e-16;
    const double x = r * 0.25, x2 = x * x;
    double ss = x * (1.0 - x2 / 6.0 * (1.0 - x2 / 20.0 * (1.0 - x2 / 42.0 * (1.0 - x2 / 72.0 * (1.0 - x2 / 110.0 * (1.0 - x2 / 156.0 * (1.0 - x2 / 210.0)))))));
    double cc = 1.0 - x2 / 2.0 * (1.0 - x2 / 12.0 * (1.0 - x2 / 30.0 * (1.0 - x2 / 56.0 * (1.0 - x2 / 90.0 * (1.0 - x2 / 132.0 * (1.0 - x2 / 182.0 * (1.0 - x2 / 240.0)))))));
    double s2 = 2.0 * ss * cc, c2 = 1.0 - 2.0 * ss * ss;
    s = 2.0 * s2 * c2; c = 1.0 - 2.0 * s2 * s2;
}

template <int MODE> __device__ __forceinline__ void cvt_T(const Ctx& C, const float* src, int K, int Nsrc, bf16* dst, int Ndst, int ldd = 0, int koff = 0) {
    if (ldd == 0) ldd = K;
    LAS float* scr = (LAS float*)(C.lds + C.wave * 8448);
    const int nblk = Ndst / 32, nitems = (K / 64) * nblk; const int lane = C.lane;
    for (int it = C.bid * 8 + C.wave; it < nitems; it += C.G * 8) {
        const int kb = it / nblk, nb = it % nblk, k0 = 64 * kb, n0 = 32 * nb; const int n = n0 + (lane & 31);
        int sn = n; if (MODE == 1) sn = (n < 2064) ? n : (n < 2304 ? -1 : n - 240);
        if (MODE == 2) sn = ((n >> 7) & 1) * DFF + (n >> 8) * 128 + (n & 127);
        float v[32];
#pragma unroll
        for (int i = 0; i < 32; ++i) v[i] = sn >= 0 ? src[(size_t)(k0 + 2 * i + (lane >> 5)) * Nsrc + sn] : 0.f;
#pragma unroll
        for (int i = 0; i < 32; ++i) scr[(2 * i + (lane >> 5)) * 33 + (lane & 31)] = v[i];
        asm volatile("s_waitcnt lgkmcnt(0)" ::: "memory");
        const int c = lane & 7;
#pragma unroll
        for (int j = 0; j < 4; ++j) { const int nn = (lane >> 3) + 8 * j; const LAS float* sp = scr + (8 * c) * 33 + nn;
            u32x4 o; o.x = pk2(sp[0 * 33], sp[1 * 33]); o.y = pk2(sp[2 * 33], sp[3 * 33]); o.z = pk2(sp[4 * 33], sp[5 * 33]); o.w = pk2(sp[6 * 33], sp[7 * 33]);
            *(u32x4*)(dst + (size_t)(n0 + nn) * ldd + koff + k0 + 8 * c) = o; }
        asm volatile("s_waitcnt lgkmcnt(0)" ::: "memory");
    }
}

__device__ __forceinline__ void pro0(const Ctx& C) {
    for (int l = 0; l < 2; ++l) {
        cvt_T<1>(C, INP(8) + (size_t)l * 1024 * 5136, 1024, 5136, WSP(bf16, WS_WIN) + (size_t)l * NIN * 1024, NIN);
        cvt_T<0>(C, INP(23) + (size_t)l * 512 * 1024, 512, 1024, WSP(bf16, WS_WBA) + (size_t)l * 1024 * 1024, 1024, 1024, 0);
        cvt_T<0>(C, INP(24) + (size_t)l * 256 * 1024, 256, 1024, WSP(bf16, WS_WBA) + (size_t)l * 1024 * 1024, 1024, 1024, 512);
        cvt_T<0>(C, INP(25) + (size_t)l * 256 * 1024, 256, 1024, WSP(bf16, WS_WBA) + (size_t)l * 1024 * 1024, 1024, 1024, 768);
        cvt_T<0>(C, INP(26) + (size_t)l * 1024 * 1024, 1024, 1024, WSP(bf16, WS_WOUT) + (size_t)l * 1024 * 1024, 1024);
        cvt_T<2>(C, INP(27) + (size_t)l * 1024 * NUP, 1024, NUP, WSP(bf16, WS_WUP) + (size_t)l * NUP * 1024, NUP);
        cvt_T<0>(C, INP(30) + (size_t)l * DFF * 1024, DFF, 1024, WSP(bf16, WS_WDN) + (size_t)l * 1024 * DFF, 1024);
        cvt_T<0>(C, INP(18) + (size_t)l * 256 * 256, 256, 256, WSP(bf16, WS_WGLU) + (size_t)l * 256 * 256, 256);
    }
    __syncthreads();
    {
        LAS float* sl = (LAS float*)C.lds;
        float* modp = WSP(float, WS_MODP);
        for (int it = C.bid; it < 384; it += C.G) {
            const int l = it / 192, r = it % 192, ks = r / 12, nb = r % 12, n = nb * 512 + C.tid;
            __syncthreads();
            for (int e = C.tid; e < 576; e += 512) { const int j = e >> 6, k = ks * 64 + (e & 63); const float cv = (j < 8) ? INP(1)[j * 1024 + k] : INP(3)[k]; sl[e] = cv / (1.0f + expf(-cv)); }
            __syncthreads();
            float a[9];
#pragma unroll
            for (int j = 0; j < 9; ++j) a[j] = 0.f;
            const float* w = INP(4) + ((size_t)l * 1024 + ks * 64) * 6144 + n;
#pragma unroll 16
            for (int k = 0; k < 64; ++k) { const float wv = w[(size_t)k * 6144];
#pragma unroll
                for (int j = 0; j < 9; ++j) a[j] += sl[j * 64 + k] * wv; }
#pragma unroll
            for (int j = 0; j < 9; ++j) modp[((size_t)(l * 16 + ks) * 9 + j) * 6144 + n] = a[j];
        }
        __syncthreads();
    }
    { float* q = WSP(float, WS_SSQ) + MTOT; for (long i = (long)C.bid * 512 + C.tid; i < (long)3 * MTOT; i += (long)C.G * 512) q[i] = 0.f; }
    const int gt = (GRID - 1 - C.bid) * 512 + C.tid;
    if (gt < 4096) {
        const int p = gt & 63, g = (gt >> 6) & 15, d = (gt >> 10) & 1, l = gt >> 11;
        const size_t pi = (((size_t)l * 2 + d) * 16 + g) * 64 + p;
        const double are = (double)INP(10)[pi], aim = (double)INP(11)[pi];
        const double dt = exp((double)INP(12)[(l * 2 + d) * 16 + g]);
        const double dre = dt * are, dim = dt * aim;
        float* lp = WSP(float, WS_LP) + pi * 66;
        double l1r = 0, l1i = 0;
        for (int k = 0; k <= 32; ++k) { double s, c; sincos_d((double)k * dim, s, c); const double mg = exp((double)k * dre); lp[2 * k] = (float)(mg * c); lp[2 * k + 1] = (float)(mg * s); if (k == 1) { l1r = mg * c; l1i = mg * s; } }
        const double den = are * are + aim * aim;
        const double cr = ((l1r - 1.0) * are + l1i * aim) / den, ci = (l1i * are - (l1r - 1.0) * aim) / den;
        float* bb = WSP(float, WS_BB) + pi * 32;
        const size_t bi = (((size_t)l * 16 + g) * 64 + p) * 16;
        for (int c = 0; c < 16; ++c) { const double br = (double)INP(13)[bi + c], bim = (double)INP(14)[bi + c]; bb[2 * c] = (float)(cr * br - ci * bim); bb[2 * c + 1] = (float)(cr * bim + ci * br); }
    }
    if (gt >= 4096 && gt < 4096 + 2048) {
        const int e = gt - 4096, pos = e >> 4, i = e & 15;
        const double inv = exp(-(double)i / 16.0 * 9.210340371976184);
        double s, c; sincos_d((double)pos * inv, s, c);
        float* rt = WSP(float, WS_ROPE) + e * 2; rt[0] = (float)c; rt[1] = (float)s;
    }
}
__device__ __forceinline__ void pro1(const Ctx& C) {
    const long gt = (long)C.bid * 512 + C.tid, NT = (long)C.G * 512;
    { const float* modp = WSP(float, WS_MODP); float* modv = WSP(float, WS_MODV);
      for (long i = gt; i < 2 * 9 * 6144; i += NT) { const int n = (int)(i % 6144), j = (int)((i / 6144) % 9), l = (int)(i / (9 * 6144)); float s = INP(5)[l * 6144 + n];
          for (int ks = 0; ks < 16; ++ks) s += modp[((size_t)(l * 16 + ks) * 9 + j) * 6144 + n];
          modv[i] = s; } }
    { const float* LP = WSP(float, WS_LP); const float* BB = WSP(float, WS_BB); float* KD = WSP(float, WS_KD);
      for (long i = gt; i < 2L * 16 * 2 * 32 * 16; i += NT) {
          const int cp = (int)(i & 15), k = (int)((i >> 4) & 31); const int lgd = __builtin_amdgcn_readfirstlane((int)(i >> 9)); const int d = lgd & 1, lg = lgd >> 1;
          const float* cre = INP(15) + (size_t)lg * 16 * 64; const float* cim = INP(16) + (size_t)lg * 16 * 64;
          const size_t pb = ((size_t)(lg >> 4) * 2 + d) * 16 * 64 + (size_t)(lg & 15) * 64;
          float acc[16];
#pragma unroll
          for (int c = 0; c < 16; ++c) acc[c] = 0.f;
          for (int p0 = 0; p0 < 64; p0 += 4) {
#pragma unroll
              for (int pp = 0; pp < 4; ++pp) { const int p = p0 + pp;
                  const float lr = LP[(pb + p) * 66 + 2 * k], li = LP[(pb + p) * 66 + 2 * k + 1]; const float br = BB[(pb + p) * 32 + 2 * cp], bi = BB[(pb + p) * 32 + 2 * cp + 1];
                  const float zr = lr * br - li * bi, zi = lr * bi + li * br;
#pragma unroll
                  for (int c = 0; c < 16; ++c) acc[c] += cre[c * 64 + p] * zr - cim[c * 64 + p] * zi; } }
#pragma unroll
          for (int c = 0; c < 16; ++c) KD[((size_t)lgd * 32 + k) * 256 + c * 16 + cp] = acc[c]; } }
    { const float* LP = WSP(float, WS_LP); const float* BB = WSP(float, WS_BB);
      bf16* W1 = WSP(bf16, WS_W1);
      for (long i = gt; i < 2L * 16 * 256 * 64; i += NT) {
          const int kc = (int)(i & 63), n = (int)((i >> 6) & 255), g = (int)((i >> 14) & 15), l = (int)(i >> 18);
          const int tau = kc >> 1, c0 = (kc & 1) * 8, p = n & 63, part = (n >> 6) & 1, d = n >> 7;
          const size_t pi = (((size_t)l * 2 + d) * 16 + g) * 64 + p; const int e = d == 0 ? 31 - tau : tau;
          const float lr = LP[pi * 66 + 2 * e], li = LP[pi * 66 + 2 * e + 1]; float v[8];
#pragma unroll
          for (int j = 0; j < 8; ++j) { const float br = BB[pi * 32 + 2 * (c0 + j)], bi = BB[pi * 32 + 2 * (c0 + j) + 1]; v[j] = part == 0 ? (lr * br - li * bi) : (lr * bi + li * br); }
          u32x4 w; w.x = pk2(v[0], v[1]); w.y = pk2(v[2], v[3]); w.z = pk2(v[4], v[5]); w.w = pk2(v[6], v[7]);
          *(u32x4*)(W1 + (((size_t)l * 16 + g) * 256 + n) * 512 + kc * 8) = w; } }
}
__device__ __forceinline__ void pro2(const Ctx& C) {
    const long gt = (long)C.bid * 512 + C.tid, NT = (long)C.G * 512;
    { const float* modv = WSP(float, WS_MODV); float* gam = WSP(float, WS_GAM);
      for (long i = gt; i < 2 * 2 * 9 * 1024; i += NT) { const int k = (int)(i & 1023), j = (int)((i >> 10) % 9), w = (int)((i / 9216) & 1), l = (int)(i / 18432);
          gam[i] = (w == 0 ? INP(6) : INP(7))[l * 1024 + k] * (1.0f + modv[((size_t)l * 9 + j) * 6144 + (w == 0 ? 1024 : 4096) + k]); } }
    { const float* modv = WSP(float, WS_MODV); LAS float* red = (LAS float*)C.lds;
      const int nbi = NIN / 128, nbu = NUP / 128, per = nbi + nbu;
      for (int it = C.bid; it < 2 * per; it += C.G) {
          const int l = it / per, r = it % per; const bool isu = r >= nbi; const int n = (isu ? r - nbi : r) * 128 + 2 * C.lane;
          int sn = n; if (!isu) sn = (n < 2064) ? n : (n < 2304 ? -1 : n - 240); else sn = ((n >> 7) & 1) * DFF + (n >> 8) * 128 + (n & 127);
          const float* W = isu ? INP(27) + (size_t)l * 1024 * NUP : INP(8) + (size_t)l * 1024 * 5136; const int ldw = isu ? NUP : 5136;
          const float* sh = modv + (size_t)l * 9 * 6144 + (isu ? 3072 : 0);
          float a0[9], a1[9];
#pragma unroll
          for (int j = 0; j < 9; ++j) { a0[j] = 0.f; a1[j] = 0.f; }
          const int kb = C.wave * 128;
#pragma unroll 8
          for (int k = kb; k < kb + 128; ++k) { f32x2_t wv = {0.f, 0.f}; if (sn >= 0) wv = *(const f32x2_t*)(W + (size_t)k * ldw + sn);
#pragma unroll
              for (int j = 0; j < 9; ++j) { const float sv = sh[(size_t)j * 6144 + k]; a0[j] += sv * wv.x; a1[j] += sv * wv.y; } }
          __syncthreads();
#pragma unroll
          for (int j = 0; j < 9; ++j) { f32x2_t o = {a0[j], a1[j]}; *(LAS f32x2_t*)(red + (C.wave * 9 + j) * 128 + 2 * C.lane) = o; }
          __syncthreads();
          for (int e = C.tid; e < 1152; e += 512) { float t = 0.f;
#pragma unroll
              for (int w = 0; w < 8; ++w) t += red[w * 1152 + e];
              const int j = e >> 7, nn = (isu ? r - nbi : r) * 128 + (e & 127);
              if (isu) WSP(float, WS_SHWU)[((size_t)l * 9 + j) * NUP + nn] = t; else WSP(float, WS_SHWI)[((size_t)l * 9 + j) * NIN + nn] = t; }
      }
      __syncthreads(); }
    const float* LP = WSP(float, WS_LP); const float* BB = WSP(float, WS_BB); const float* KD = WSP(float, WS_KD);
    { bf16* W2 = WSP(bf16, WS_W2);
      for (long i = gt; i < 2L * 16 * 512 * 96; i += NT) {
          const int kc = (int)(i % 96); const long r = i / 96; const int n = (int)(r & 511), g = (int)((r >> 9) & 15), l = (int)(r >> 13);
          const int t = n >> 4, c = n & 15; float v[8];
          if (kc < 64) { const int tau = kc >> 1, c0 = (kc & 1) * 8;
              const float* kf = KD + ((((size_t)l * 16 + g) * 2 + 0) * 32) * 256; const float* kb = KD + ((((size_t)l * 16 + g) * 2 + 1) * 32) * 256;
#pragma unroll
              for (int j = 0; j < 8; ++j) { const int cp = c0 + j; float s = 0.f;
                  if (tau <= t) s += kf[(t - tau) * 256 + c * 16 + cp];
                  if (tau >= t) s += kb[(tau - t) * 256 + c * 16 + cp];
                  if (tau == t && cp == c) s += INP(17)[l * 256 + g * 16 + c];
                  v[j] = s; }
          } else { const int kk = (kc - 64) * 8; const int d = kk >> 7, part = (kk >> 6) & 1, p0 = kk & 63; const int e = d == 0 ? t + 1 : 32 - t;
              const float* cre = INP(15) + (((size_t)l * 16 + g) * 16 + c) * 64; const float* cim = INP(16) + (((size_t)l * 16 + g) * 16 + c) * 64;
#pragma unroll
              for (int j = 0; j < 8; ++j) { const int p = p0 + j; const size_t pi = (((size_t)l * 2 + d) * 16 + g) * 64 + p; const float lr = LP[pi * 66 + 2 * e], li = LP[pi * 66 + 2 * e + 1];
                  const float zr = cre[p] * lr - cim[p] * li, zi = cre[p] * li + cim[p] * lr; v[j] = part == 0 ? zr : -zi; } }
          u32x4 w; w.x = pk2(v[0], v[1]); w.y = pk2(v[2], v[3]); w.z = pk2(v[4], v[5]); w.w = pk2(v[6], v[7]);
          *(u32x4*)(W2 + (((size_t)l * 16 + g) * 512 + n) * 768 + kc * 8) = w; } }
}

__device__ __forceinline__ void norm_emit_phase(const Ctx& C, const float* xlat, const float* xctx, const float* gain, const float* modl  , bf16* hn, float* ssq, int nrows) {
    const int gw = C.bid * 8 + C.wave, NGW = C.G * 8;
    auto rowp = [&](int r) -> const f32x4* { return (const f32x4*)(r < MLAT ? xlat + (size_t)r * DM : xctx + (size_t)(r - MLAT) * DM) + C.lane; };
    f32x4 v[4], nv[4];
    { const f32x4* x4 = rowp(gw < nrows ? gw : 0);
#pragma unroll
      for (int q = 0; q < 4; ++q) v[q] = x4[64 * q]; }
    for (int r = gw; r < nrows; r += NGW) {
        { const f32x4* n4 = rowp(r + NGW < nrows ? r + NGW : r);
#pragma unroll
          for (int q = 0; q < 4; ++q) nv[q] = n4[64 * q]; }
        const int j = r < MLAT ? (r >> 13) : 8; float s = 0.f;
#pragma unroll
        for (int q = 0; q < 4; ++q) s += (v[q].x * v[q].x + v[q].y * v[q].y) + (v[q].z * v[q].z + v[q].w * v[q].w);
        s = wave_sum(s);
        if (C.lane == 0) ssq[r] = s;
        const float* sv = modl + (size_t)j * 6144 + 1024;
        unsigned long long* o8 = (unsigned long long*)(hn + (size_t)r * DM) + C.lane;
#pragma unroll
        for (int q = 0; q < 4; ++q) { const f32x4 y = v[q] * (*(const f32x4*)(gain + 4 * C.lane + 256 * q) * (*(const f32x4*)(sv + 4 * C.lane + 256 * q) + 1.0f));
            o8[64 * q] = (unsigned long long)pk2(y.x, y.y) | ((unsigned long long)pk2(y.z, y.w) << 32); }
#pragma unroll
        for (int q = 0; q < 4; ++q) v[q] = nv[q];
    }
}
__device__ __forceinline__ void final_norm_phase(const Ctx& C, float* x, const float* gain) {
    const int gw = C.bid * 8 + C.wave, NGW = C.G * 8;
    f32x4 v[4], nv[4];
    { const f32x4* x4 = (const f32x4*)(x + (size_t)(gw < MLAT ? gw : 0) * DM) + C.lane;
#pragma unroll
      for (int q = 0; q < 4; ++q) v[q] = x4[64 * q]; }
    f32x4 gg[4];
#pragma unroll
    for (int q = 0; q < 4; ++q) gg[q] = *(const f32x4*)(gain + 4 * C.lane + 256 * q);
    for (int r = gw; r < MLAT; r += NGW) {
        { const f32x4* n4 = (const f32x4*)(x + (size_t)(r + NGW < MLAT ? r + NGW : r) * DM) + C.lane;
#pragma unroll
          for (int q = 0; q < 4; ++q) nv[q] = n4[64 * q]; }
        float s = 0.f;
#pragma unroll
        for (int q = 0; q < 4; ++q) s += (v[q].x * v[q].x + v[q].y * v[q].y) + (v[q].z * v[q].z + v[q].w * v[q].w);
        const float rs = 1.0f / sqrtf(wave_sum(s) * (1.0f / DM) + NORM_EPS);
        f32x4* x4 = (f32x4*)(x + (size_t)r * DM) + C.lane;
#pragma unroll
        for (int q = 0; q < 4; ++q) x4[64 * q] = v[q] * rs * gg[q];
#pragma unroll
        for (int q = 0; q < 4; ++q) v[q] = nv[q];
    }
}
__device__ __forceinline__ void rope_phase(const Ctx& C) {
    bf16* z1 = WSP(bf16, WS_Z1); const float* rt = WSP(float, WS_ROPE);
    constexpr long total = (long)MLAT * 40, NT = (long)GRID * 512; static_assert(total % (4 * NT) == 0, "four items per thread and trip");
    for (long i0 = (long)C.bid * 512 + C.tid; i0 < total; i0 += 4 * NT) {
        bf16* p[4]; const float* cs[4]; u32x4 a[4], b[4];
#pragma unroll
        for (int u = 0; u < 4; ++u) { const long i = i0 + u * NT;
            const int e = (int)(i % 40); const int row = (int)(i / 40); const int head = e >> 2, half = (e >> 1) & 1, ic = e & 1; const int t = row & 8191;
            p[u] = z1 + (size_t)row * ZP + (head < 8 ? head * 64 : 512 + (head - 8) * 64) + half * 32 + ic * 8;
            const int pos = half == 0 ? (t >> 6) : (t & 63); cs[u] = rt + (pos * 16 + ic * 8) * 2;
            a[u] = *(const u32x4*)p[u]; b[u] = *(const u32x4*)(p[u] + 16); }
#pragma unroll
        for (int u = 0; u < 4; ++u) {
            const unsigned aw[4] = {a[u].x, a[u].y, a[u].z, a[u].w}, bw[4] = {b[u].x, b[u].y, b[u].z, b[u].w}; unsigned oa[4], ob[4];
#pragma unroll
            for (int q = 0; q < 4; ++q) { const f32x4 c4 = *(const f32x4*)(cs[u] + 4 * q); const float c0 = c4.x, s0 = c4.y, c1 = c4.z, s1 = c4.w;
                const float u10 = bflo(aw[q]), u11 = bfhi(aw[q]), u20 = bflo(bw[q]), u21 = bfhi(bw[q]);
                oa[q] = pk2(u10 * c0 - u20 * s0, u11 * c1 - u21 * s1); ob[q] = pk2(u20 * c0 + u10 * s0, u21 * c1 + u11 * s1); }
            u32x4 wa, wb; wa.x = oa[0]; wa.y = oa[1]; wa.z = oa[2]; wa.w = oa[3]; wb.x = ob[0]; wb.y = ob[1]; wb.z = ob[2]; wb.w = ob[3];
            *(u32x4*)p[u] = wa; *(u32x4*)(p[u] + 16) = wb; }
    }
}
__device__ __forceinline__ void conv_phase(const Ctx& C, const bf16* u, bf16* act, const float* cw, const float* cb, int rbase, int nrows) {
    const long total = (long)(nrows / 32) * (DFF / 8);
    for (long i = (long)C.bid * 512 + C.tid; i < total; i += (long)C.G * 512) {
        const int jc = (int)(i % (DFF / 8)), blk = (int)(i / (DFF / 8)); const int rl0 = blk * 32, r0 = rbase + rl0, j0 = jc * 8;
        const int t0 = r0 < MLAT ? (r0 & 8191) : ((r0 - MLAT) & 255); const int len = r0 < MLAT ? 8192 : 256;
        float wa[3][8], wv[3][8], ba[8], bv[8];
#pragma unroll
        for (int h = 0; h < 2; ++h) {
#pragma unroll
            for (int k = 0; k < 3; ++k) { const f32x4 x = *(const f32x4*)(cw + k * NUP + j0 + 4 * h), y = *(const f32x4*)(cw + k * NUP + DFF + j0 + 4 * h);
#pragma unroll
                for (int e = 0; e < 4; ++e) { wa[k][4 * h + e] = x[e]; wv[k][4 * h + e] = y[e]; } }
            const f32x4 x = *(const f32x4*)(cb + j0 + 4 * h), y = *(const f32x4*)(cb + DFF + j0 + 4 * h);
#pragma unroll
            for (int e = 0; e < 4; ++e) { ba[4 * h + e] = x[e]; bv[4 * h + e] = y[e]; } }
        const bf16* ua = u + (size_t)rl0 * NUP + j0; bf16* ap = act + (size_t)rl0 * DFF + j0;
        const u32x4 z = {0u, 0u, 0u, 0u};
        u32x4 pa = t0 > 0 ? *(const u32x4*)(ua - NUP) : z, pv = t0 > 0 ? *(const u32x4*)(ua - NUP + DFF) : z;
        u32x4 ca = *(const u32x4*)ua, cv = *(const u32x4*)(ua + DFF);
        for (int k0 = 0; k0 < 32; k0 += 4) {
            u32x4 na[4], nv[4];
#pragma unroll
            for (int kk = 0; kk < 4; ++kk) { const int k = k0 + kk; const bool hn = (t0 + k) < len - 1;
                na[kk] = hn ? *(const u32x4*)(ua + (size_t)(k + 1) * NUP) : z; nv[kk] = hn ? *(const u32x4*)(ua + (size_t)(k + 1) * NUP + DFF) : z; }
#pragma unroll
            for (int kk = 0; kk < 4; ++kk) { const int k = k0 + kk;
                const unsigned P[4] = {pa.x, pa.y, pa.z, pa.w}, Cc[4] = {ca.x, ca.y, ca.z, ca.w}, N[4] = {na[kk].x, na[kk].y, na[kk].z, na[kk].w}, PV[4] = {pv.x, pv.y, pv.z, pv.w}, CV[4] = {cv.x, cv.y, cv.z, cv.w}, NV[4] = {nv[kk].x, nv[kk].y, nv[kk].z, nv[kk].w};
                unsigned o[4];
#pragma unroll
                for (int q = 0; q < 4; ++q) {
                    const float a0 = bflo(P[q]) * wa[0][2 * q] + bflo(Cc[q]) * wa[1][2 * q] + bflo(N[q]) * wa[2][2 * q] + ba[2 * q];
                    const float a1 = bfhi(P[q]) * wa[0][2 * q + 1] + bfhi(Cc[q]) * wa[1][2 * q + 1] + bfhi(N[q]) * wa[2][2 * q + 1] + ba[2 * q + 1];
                    const float v0 = bflo(PV[q]) * wv[0][2 * q] + bflo(CV[q]) * wv[1][2 * q] + bflo(NV[q]) * wv[2][2 * q] + bv[2 * q];
                    const float v1 = bfhi(PV[q]) * wv[0][2 * q + 1] + bfhi(CV[q]) * wv[1][2 * q + 1] + bfhi(NV[q]) * wv[2][2 * q + 1] + bv[2 * q + 1];
                    o[q] = pk2(a0 * sigmoidf_(a0) * v0, a1 * sigmoidf_(a1) * v1); }
                u32x4 w; w.x = o[0]; w.y = o[1]; w.z = o[2]; w.w = o[3];
                *(u32x4*)(ap + (size_t)k * DFF) = w;
                pa = ca; ca = na[kk]; pv = cv; cv = nv[kk]; }
        }
    }
}

__device__ __forceinline__ void seam_phase(const Ctx& C, const float* raw, bf16* act, const float* cw, const float* cb, int ntiles) {
    const long total = (long)ntiles * 2 * (DFF / 8);
    for (long i = (long)C.bid * 512 + C.tid; i < total; i += (long)C.G * 512) {
        const int jc = (int)(i % (DFF / 8)); const int rr = (int)(i / (DFF / 8)); const int pm = rr >> 1, last = rr & 1; const int ch = jc * 8, pn = ch >> 7, ci = ch & 127;
        const int r = pm * 256 + (last ? 255 : 0); const int t = r < MLAT ? (r & 8191) : ((r - MLAT) & 255); const int len = r < MLAT ? 8192 : 256;
        const float* base = raw + (size_t)pm * 4 * NUP + pn * 256 + ci;
        const float* pp = last ? base + 2 * NUP : (t > 0 ? base - 4 * NUP + 3 * NUP : nullptr);
        const float* cp = last ? base + 3 * NUP : base;
        const float* np = last ? (t < len - 1 ? base + 4 * NUP : nullptr) : base + NUP;
        float res[8];
#pragma unroll
        for (int h = 0; h < 2; ++h) {
            f32x4 A[3], V[3]; const f32x4 z = {0.f, 0.f, 0.f, 0.f};
            A[0] = pp ? *(const f32x4*)(pp + 4 * h) : z; V[0] = pp ? *(const f32x4*)(pp + 128 + 4 * h) : z;
            A[1] = *(const f32x4*)(cp + 4 * h); V[1] = *(const f32x4*)(cp + 128 + 4 * h);
            A[2] = np ? *(const f32x4*)(np + 4 * h) : z; V[2] = np ? *(const f32x4*)(np + 128 + 4 * h) : z;
            f32x4 a = *(const f32x4*)(cb + ch + 4 * h), v = *(const f32x4*)(cb + DFF + ch + 4 * h);
#pragma unroll
            for (int k = 0; k < 3; ++k) { a += A[k] * *(const f32x4*)(cw + k * NUP + ch + 4 * h); v += V[k] * *(const f32x4*)(cw + k * NUP + DFF + ch + 4 * h); }
#pragma unroll
            for (int e = 0; e < 4; ++e) res[4 * h + e] = a[e] * sigmoidf_(a[e]) * v[e];
        }
        u32x4 w; w.x = pk2(res[0], res[1]); w.y = pk2(res[2], res[3]); w.z = pk2(res[4], res[5]); w.w = pk2(res[6], res[7]);
        *(u32x4*)(act + (size_t)r * DFF + ch) = w;
    }
}

__device__ __forceinline__ f32x16 mfma32(bf16x8 a, bf16x8 b, f32x16 c) { return __builtin_amdgcn_mfma_f32_32x32x16_bf16(a, b, c, 0, 0, 0); }
__device__ __forceinline__ void attn_unit(const Ctx& C, bf16* z1, const float* sinkp, int b, int kvh, int q0, bool isctx) {
    constexpr int KB = 64 * 72 * 2, VB = 64 * 68 * 2, BUF = KB + VB + 64;
    const int w = C.wave, lane = C.lane, g = w >> 1, th = w & 1, c = lane & 31, hh = lane >> 5;
    const int qtok = q0 + th * 32 + c;
    const size_t qrow = isctx ? (size_t)MLAT + b * 256 + qtok : (size_t)b * 8192 + qtok;
    bf16* qptr = z1 + qrow * ZP + kvh * 256 + g * 64;
    int first = 0, nloc = 0;
    if (!isctx) { first = q0 >= 128 ? 0 : (q0 >= 64 ? 1 : 2); const int last = q0 + 128 < SEQ ? 4 : (q0 + 64 < SEQ ? 3 : 2); nloc = last - first + 1; }
    const int nt = nloc + 4;
    const bf16* kvbase = z1 + 512 + kvh * 64 + 8 * w;
    auto tile_row0 = [&](int t, int& kpos0) -> size_t { if (t < nloc) { kpos0 = q0 - 128 + 64 * (first + t); return (size_t)b * 8192 + kpos0; } kpos0 = 64 * (t - nloc); return (size_t)MLAT + b * 256 + kpos0; };
    int kp0; size_t r0 = tile_row0(0, kp0);
    u32x4 kv = *(const u32x4*)(kvbase + (r0 + lane) * ZP), vv = *(const u32x4*)(kvbase + (r0 + lane) * ZP + 128);
    bf16x8 qf[4];
#pragma unroll
    for (int s = 0; s < 4; ++s) qf[s] = *(const bf16x8*)(qptr + 16 * s + 8 * hh);
    const float L2E = 1.4426950408889634f;
    float m_run = sinkp[kvh * 4 + g] * L2E, l_run = hh == 0 ? 1.0f : 0.0f;
    f32x16 ot[2];
#pragma unroll
    for (int i = 0; i < 16; ++i) { ot[0][i] = 0.f; ot[1][i] = 0.f; }
    __syncthreads();
    for (int t = 0; t < nt; ++t) {
        LAS bf16* Ks = (LAS bf16*)(C.lds + (t & 1) * BUF); LAS bf16* VT = (LAS bf16*)(C.lds + (t & 1) * BUF + KB);
        { *(LAS u32x4*)(Ks + lane * 72 + 8 * w) = kv;
          const unsigned vw[4] = {vv.x, vv.y, vv.z, vv.w};
#pragma unroll
          for (int q = 0; q < 4; ++q) { VT[(8 * w + 2 * q) * 68 + lane] = (bf16)(vw[q] & 0xffffu); VT[(8 * w + 2 * q + 1) * 68 + lane] = (bf16)(vw[q] >> 16); } }
        const int kpos0 = kp0; const bool edge = t < nloc && (kpos0 == q0 - 128 || kpos0 == q0 + 128);
        if (t + 1 < nt) { r0 = tile_row0(t + 1, kp0); kv = *(const u32x4*)(kvbase + (r0 + lane) * ZP); vv = *(const u32x4*)(kvbase + (r0 + lane) * ZP + 128); }
        __syncthreads();
        f32x16 st[2];
#pragma unroll
        for (int kh = 0; kh < 2; ++kh) {
#pragma unroll
            for (int i = 0; i < 16; ++i) st[kh][i] = 0.f;
#pragma unroll
            for (int s = 0; s < 4; ++s) { const bf16x8 kf = *(const LAS bf16x8*)(Ks + (32 * kh + c) * 72 + 16 * s + 8 * hh); st[kh] = mfma32(kf, qf[s], st[kh]); }
        }
        if (edge) {
            asm volatile("");
#pragma unroll
            for (int kh = 0; kh < 2; ++kh)
#pragma unroll
                for (int i = 0; i < 16; ++i) { const int kp = kpos0 + 32 * kh + (i & 3) + 8 * (i >> 2) + 4 * hh; const int dd = qtok - kp; if (dd > 128 || dd < -128) st[kh][i] = -INFINITY; }
        }
        float mx = -INFINITY;
#pragma unroll
        for (int kh = 0; kh < 2; ++kh)
#pragma unroll
            for (int i = 0; i < 16; ++i) mx = fmaxf(mx, st[kh][i]);
        mx = fmaxf(mx, __shfl_xor(mx, 32));
        if (__builtin_amdgcn_ballot_w64(mx > m_run + 8.0f) != 0ull) {
            const float m_new = fmaxf(m_run, mx); const float alpha = __builtin_amdgcn_exp2f(m_run - m_new); m_run = m_new; l_run *= alpha;
#pragma unroll
            for (int i = 0; i < 16; ++i) { ot[0][i] *= alpha; ot[1][i] *= alpha; } }
        { const f32x16 d0 = st[0] - m_run, d1 = st[1] - m_run;
#pragma unroll
          for (int i = 0; i < 16; ++i) { st[0][i] = __builtin_amdgcn_exp2f(d0[i]); st[1][i] = __builtin_amdgcn_exp2f(d1[i]); } }
        const f32x16 s16 = st[0] + st[1]; const f32x8 s8 = s16.lo + s16.hi; const f32x4 s4 = s8.lo + s8.hi;
        l_run += (s4.x + s4.y) + (s4.z + s4.w);
#pragma unroll
        for (int kh = 0; kh < 2; ++kh)
#pragma unroll
            for (int s2 = 0; s2 < 2; ++s2) {
                u32x4 pw; pw.x = pk2(st[kh][8 * s2 + 0], st[kh][8 * s2 + 1]); pw.y = pk2(st[kh][8 * s2 + 2], st[kh][8 * s2 + 3]); pw.z = pk2(st[kh][8 * s2 + 4], st[kh][8 * s2 + 5]); pw.w = pk2(st[kh][8 * s2 + 6], st[kh][8 * s2 + 7]);
                const bf16x8 pf = __builtin_bit_cast(bf16x8, pw);
#pragma unroll
                for (int db = 0; db < 2; ++db) { const LAS bf16* vp = VT + (32 * db + c) * 68 + 32 * kh + 16 * s2 + 4 * hh;
                    const u32x2 lo = *(const LAS u32x2*)vp, hi = *(const LAS u32x2*)(vp + 8); u32x4 vw2; vw2.x = lo.x; vw2.y = lo.y; vw2.z = hi.x; vw2.w = hi.y;
                    ot[db] = mfma32(__builtin_bit_cast(bf16x8, vw2), pf, ot[db]); }
            }
    }
    const float lt = l_run + __shfl_xor(l_run, 32); const float inv = 1.0f / lt;
#pragma unroll
    for (int db = 0; db < 2; ++db)
#pragma unroll
        for (int i4 = 0; i4 < 4; ++i4) { u32x2 o; o.x = pk2(ot[db][4 * i4] * inv, ot[db][4 * i4 + 1] * inv); o.y = pk2(ot[db][4 * i4 + 2] * inv, ot[db][4 * i4 + 3] * inv);
            *(u32x2*)(qptr + 32 * db + 8 * i4 + 4 * hh) = o; }
}

__device__ __forceinline__ void ml_gate_tables(const Ctx& C, LAS float* tab, float g_i, float g_f) {
    if (C.wave < 2) { const int dir = C.wave, s = C.lane;
        const float lf = g_f; const float ig = g_i;
        float cs = lf;
#pragma unroll
        for (int o = 1; o < 64; o <<= 1) { const float nb = dir == 0 ? __shfl_up(cs, o) : __shfl_down(cs, o); const bool ok = dir == 0 ? (s >= o) : (s + o < 64); cs += ok ? nb : 0.f; }
        tab[dir * 192 + s] = cs; tab[dir * 192 + 64 + s] = ig - cs;
        const float tot = __shfl(cs, dir == 0 ? 63 : 0); if (s == 0) tab[dir * 192 + 128] = tot; }
}
struct MlaIn { u32x4 kv, vv; float gi0, gf0, gi1, gf1; };
__device__ __forceinline__ void mlA_load(const Ctx& C, int cidx, int h, MlaIn& R) {
    const bf16* z1 = WSP(bf16, WS_Z1); const float* gm = WSP(float, WS_GM); const int r0 = cidx * 64;
    const bf16* kp = z1 + (size_t)(r0 + C.lane) * ZP + 1024 + h * 64 + 8 * C.wave;
    R.kv = *(const u32x4*)kp; R.vv = *(const u32x4*)(kp + 256);
    const float* gr = gm + (size_t)(r0 + C.lane) * 16 + h; R.gi0 = gr[0]; R.gf0 = gr[4]; R.gi1 = gr[8]; R.gf1 = gr[12];
}
__device__ __forceinline__ void mlA_compute(const Ctx& C, int l, int cidx, int h, const MlaIn& R, int par) {
    LAS unsigned char* base = C.lds + par * 32768;
    LAS float* tab = (LAS float*)base;
    LAS bf16* KT = (LAS bf16*)(base + 2048);
    LAS bf16* VF = (LAS bf16*)(base + 2048 + 9216);
    LAS bf16* VB = (LAS bf16*)(base + 2048 + 2 * 9216);
    const int w = C.wave, lane = C.lane;
    const u32x4 kv = R.kv, vv = R.vv;
    float csf = R.gf0, csb = R.gf1;
#pragma unroll
    for (int o = 1; o < 64; o <<= 1) { const float nf = __shfl_up(csf, o), nb = __shfl_down(csb, o); csf += lane >= o ? nf : 0.f; csb += lane + o < 64 ? nb : 0.f; }
    const float totf = __shfl(csf, 63), totb = __shfl(csb, 0);
    { const float wf = __expf(totf + (R.gi0 - csf)), wb = __expf(totb + (R.gi1 - csb));
      const unsigned kw[4] = {kv.x, kv.y, kv.z, kv.w}, vw[4] = {vv.x, vv.y, vv.z, vv.w};
#pragma unroll
      for (int q = 0; q < 4; ++q) { const int d0 = 8 * w + 2 * q;
          KT[d0 * 72 + lane] = (bf16)(kw[q] & 0xffffu); KT[(d0 + 1) * 72 + lane] = (bf16)(kw[q] >> 16);
          const float v0 = bflo(vw[q]), v1 = bfhi(vw[q]);
          VF[d0 * 72 + lane] = f2bf(v0 * wf); VF[(d0 + 1) * 72 + lane] = f2bf(v1 * wf);
          VB[d0 * 72 + lane] = f2bf(v0 * wb); VB[(d0 + 1) * 72 + lane] = f2bf(v1 * wb); }
      if (w == 0) { tab[lane] = wf; tab[64 + lane] = wb; if (lane == 0) { tab[128] = totf; tab[129] = totb; } } }
    __syncthreads();
    const int dir = w >> 2, dblk = (w >> 1) & 1, eblk = w & 1, c = lane & 31, hh = lane >> 5;
    const LAS bf16* VX = dir == 0 ? VF : VB;
    f32x16 acc;
#pragma unroll
    for (int i = 0; i < 16; ++i) acc[i] = 0.f;
#pragma unroll
    for (int s = 0; s < 4; ++s) { const bf16x8 a = *(const LAS bf16x8*)(KT + (32 * dblk + c) * 72 + 16 * s + 8 * hh), bb = *(const LAS bf16x8*)(VX + (32 * eblk + c) * 72 + 16 * s + 8 * hh); acc = mfma32(a, bb, acc); }
    const size_t idx = ((size_t)cidx * 4 + h) * 2 + dir;
    bf16* dc = WSP(bf16, WS_DC) + idx * 4096 + (32 * eblk + c) * 64 + 32 * dblk + 4 * hh;
#pragma unroll
    for (int i4 = 0; i4 < 4; ++i4) { u32x2 o; o.x = pk2(acc[4 * i4], acc[4 * i4 + 1]); o.y = pk2(acc[4 * i4 + 2], acc[4 * i4 + 3]); *(u32x2*)(dc + 8 * i4) = o; }
    if (C.tid < 128) { const int dd = C.tid >> 6, d = C.tid & 63; float s = 0.f;
#pragma unroll
        for (int k8 = 0; k8 < 8; ++k8) { const u32x4 kk = *(const LAS u32x4*)(KT + d * 72 + 8 * k8); const LAS float* wp = tab + dd * 64 + 8 * k8; const f32x4 w0 = *(const LAS f32x4*)wp, w1 = *(const LAS f32x4*)(wp + 4);
            s += ((w0[0] * bflo(kk.x) + w0[1] * bfhi(kk.x)) + (w0[2] * bflo(kk.y) + w0[3] * bfhi(kk.y))) + ((w1[0] * bflo(kk.z) + w1[1] * bfhi(kk.z)) + (w1[2] * bflo(kk.w) + w1[3] * bfhi(kk.w))); }
        WSP(float, WS_DN)[(((size_t)cidx * 4 + h) * 2 + dd) * 64 + d] = s;
        if (d == 0) WSP(float, WS_BEND)[((size_t)cidx * 4 + h) * 2 + dd] = tab[128 + dd]; }
}
__device__ __forceinline__ void ml_carry_unit(const Ctx& C, int chain) {
    const int dir = chain & 1, h = (chain >> 1) & 3, b = chain >> 3;
    const bf16* DCp = WSP(bf16, WS_DC); bf16* CIN = WSP(bf16, WS_CIN); const float* DN = WSP(float, WS_DN); float* NINp = WSP(float, WS_NIN); const float* BEND = WSP(float, WS_BEND);
    float zz = 0.f; asm volatile("" : "+v"(zz));
    float st[8]; float ns = zz;
#pragma unroll
    for (int j = 0; j < 8; ++j) st[j] = zz;
    const int nl = C.tid & 63;
    size_t idx[4], nidx[4]; u32x4 dv[4], ndv[4]; float be[4], dn[4], nbe[4], ndn[4];
#define MLC_LOAD(S0, IDX, DV, BE, DNV) _Pragma("unroll") for (int k = 0; k < 4; ++k) { const int step = (S0) + k; const int cidx = (S0) == 0 ? 1024 + b * 4 + (dir == 0 ? step : 3 - step) : b * 128 + (dir == 0 ? step - 4 : 131 - step); \
            IDX[k] = ((size_t)cidx * 4 + h) * 2 + dir; DV[k] = *(const u32x4*)(DCp + IDX[k] * 4096 + C.tid * 8); BE[k] = BEND[IDX[k]]; DNV[k] = DN[IDX[k] * 64 + nl]; }
    MLC_LOAD(0, idx, dv, be, dn)
    for (int s0 = 0; s0 < 132; s0 += 4) {
        const int sn = s0 + 4 < 132 ? s0 + 4 : s0;
        MLC_LOAD(sn, nidx, ndv, nbe, ndn)
#pragma unroll
        for (int k = 0; k < 4; ++k) {
            u32x4 o; o.x = pk2(st[0], st[1]); o.y = pk2(st[2], st[3]); o.z = pk2(st[4], st[5]); o.w = pk2(st[6], st[7]);
            *(u32x4*)(CIN + idx[k] * 4096 + C.tid * 8) = o;
            const float dec = __expf(be[k]);
            st[0] = dec * st[0] + bflo(dv[k].x); st[1] = dec * st[1] + bfhi(dv[k].x); st[2] = dec * st[2] + bflo(dv[k].y); st[3] = dec * st[3] + bfhi(dv[k].y);
            st[4] = dec * st[4] + bflo(dv[k].z); st[5] = dec * st[5] + bfhi(dv[k].z); st[6] = dec * st[6] + bflo(dv[k].w); st[7] = dec * st[7] + bfhi(dv[k].w);
            if (C.tid < 64) NINp[idx[k] * 64 + C.tid] = ns;
            ns = dec * ns + dn[k];
        }
#pragma unroll
        for (int k = 0; k < 4; ++k) { idx[k] = nidx[k]; dv[k] = ndv[k]; be[k] = nbe[k]; dn[k] = ndn[k]; }
    }
#undef MLC_LOAD
}
struct MlcIn { u32x4 vv, kk, qq, c0, c1, ogate; f32x4 ng0, ng1; float g_i, g_f, nin; };
__device__ __forceinline__ void mlC_load(const Ctx& C, int l, int cidx, int h, MlcIn& R) {
    const bf16* z1 = WSP(bf16, WS_Z1); const float* gm = WSP(float, WS_GM);
    const int r0 = cidx * 64, w = C.wave, lane = C.lane;
    const bf16* rp = z1 + (size_t)(r0 + lane) * ZP + h * 64 + 8 * w;
    R.qq = *(const u32x4*)(rp + 768); R.kk = *(const u32x4*)(rp + 1024); R.vv = *(const u32x4*)(rp + 1280);
    { const int row = C.tid >> 2, ch = C.tid & 3; const bf16* cp = WSP(bf16, WS_CIN) + (((size_t)cidx * 4 + h) * 2 + (row >> 6)) * 4096 + (row & 63) * 64 + 16 * ch; R.c0 = *(const u32x4*)cp; R.c1 = *(const u32x4*)(cp + 8); }
    R.ogate = *(const u32x4*)(z1 + (size_t)(r0 + (C.tid >> 3)) * ZP + 1536 + h * 64 + (C.tid & 7) * 8);
    const float* ng = INP(22) + l * 256 + h * 64 + (C.tid & 7) * 8; R.ng0 = *(const f32x4*)ng; R.ng1 = *(const f32x4*)(ng + 4);
    const float* gr = gm + (size_t)(r0 + lane) * 16 + (w & 1) * 8 + h; R.g_i = gr[0]; R.g_f = gr[4];
    R.nin = WSP(float, WS_NIN)[(((size_t)cidx * 4 + h) * 2 + ((C.tid >> 6) & 1)) * 64 + lane];
}
__device__ __forceinline__ void mlC_compute(const Ctx& C, int l, int cidx, int h, const MlcIn& R, int par) {
    bf16* z1 = WSP(bf16, WS_Z1);
    LAS unsigned char* base = C.lds + par * 64256;
    LAS float* tab = (LAS float*)base;
    LAS bf16* VT = (LAS bf16*)(base + 2048);
    LAS float* Hs = (LAS float*)(base + 2048 + 8704);
    LAS bf16* Ks = (LAS bf16*)(base + 27392);
    LAS bf16* Qs = (LAS bf16*)(base + 27392 + 9216);
    LAS bf16* Cs = (LAS bf16*)(base + 27392 + 2 * 9216);
    const int r0 = cidx * 64, w = C.wave, lane = C.lane;
    const int dir = w >> 2, eblk = (w >> 1) & 1, tblk = w & 1, c = lane & 31, hh = lane >> 5; const int t = 32 * tblk + c;
    ml_gate_tables(C, tab, R.g_i, R.g_f);
    if (C.tid < 128) tab[384 + C.tid] = R.nin;
    { const unsigned vw[4] = {R.vv.x, R.vv.y, R.vv.z, R.vv.w};
#pragma unroll
      for (int q = 0; q < 4; ++q) { VT[(8 * w + 2 * q) * 68 + lane] = (bf16)(vw[q] & 0xffffu); VT[(8 * w + 2 * q + 1) * 68 + lane] = (bf16)(vw[q] >> 16); }
      *(LAS u32x4*)(Ks + lane * 72 + 8 * w) = R.kk; *(LAS u32x4*)(Qs + lane * 72 + 8 * w) = R.qq;
      const int row = C.tid >> 2, ch = C.tid & 3; *(LAS u32x4*)(Cs + row * 72 + 16 * ch) = R.c0; *(LAS u32x4*)(Cs + row * 72 + 16 * ch + 8) = R.c1; }
    __syncthreads();
    bf16x8 qf[4];
#pragma unroll
    for (int s = 0; s < 4; ++s) qf[s] = *(const LAS bf16x8*)(Qs + t * 72 + 16 * s + 8 * hh);
    const float bct = tab[dir * 192 + t];
    float nq = 0.f;
#pragma unroll
    for (int s = 0; s < 4; ++s) { const u32x4 qw = __builtin_bit_cast(u32x4, qf[s]); const LAS float* np = tab + 384 + dir * 64 + 16 * s + 8 * hh; const f32x4 n0 = *(const LAS f32x4*)np, n1 = *(const LAS f32x4*)(np + 4);
        nq += n0[0] * bflo(qw.x) + n0[1] * bfhi(qw.x) + n0[2] * bflo(qw.y) + n0[3] * bfhi(qw.y) + n1[0] * bflo(qw.z) + n1[1] * bfhi(qw.z) + n1[2] * bflo(qw.w) + n1[3] * bfhi(qw.w); }
    nq += __shfl_xor(nq, 32);
    f32x16 acc, acc2;
#pragma unroll
    for (int i = 0; i < 16; ++i) { acc[i] = 0.f; acc2[i] = 0.f; }
    float dsum = 0.f;
#pragma unroll
    for (int sb = 0; sb < 2; ++sb) {
        f32x16 st;
#pragma unroll
        for (int i = 0; i < 16; ++i) st[i] = 0.f;
#pragma unroll
        for (int s = 0; s < 4; ++s) { const bf16x8 kf = *(const LAS bf16x8*)(Ks + (32 * sb + c) * 72 + 16 * s + 8 * hh); st = mfma32(kf, qf[s], st); }
#pragma unroll
        for (int j = 0; j < 4; ++j) { const f32x4 tv = *(const LAS f32x4*)(tab + dir * 192 + 64 + 32 * sb + 8 * j + 4 * hh);
#pragma unroll
            for (int e = 0; e < 4; ++e) { const int i = 4 * j + e, s = 32 * sb + e + 8 * j + 4 * hh; const bool ok = dir == 0 ? (s <= t) : (s >= t);
                const float wgt = __expf(ok ? bct + tv[e] : -INFINITY); const float p = wgt * st[i]; st[i] = p; dsum += p; } }
#pragma unroll
        for (int s2 = 0; s2 < 2; ++s2) {
            u32x4 pw; pw.x = pk2(st[8 * s2 + 0], st[8 * s2 + 1]); pw.y = pk2(st[8 * s2 + 2], st[8 * s2 + 3]); pw.z = pk2(st[8 * s2 + 4], st[8 * s2 + 5]); pw.w = pk2(st[8 * s2 + 6], st[8 * s2 + 7]);
            const LAS bf16* vp = VT + (32 * eblk + c) * 68 + 32 * sb + 16 * s2 + 4 * hh;
            const u32x2 lo = *(const LAS u32x2*)vp, hi = *(const LAS u32x2*)(vp + 8); u32x4 vw; vw.x = lo.x; vw.y = lo.y; vw.z = hi.x; vw.w = hi.y;
            acc = mfma32(__builtin_bit_cast(bf16x8, vw), __builtin_bit_cast(bf16x8, pw), acc); }
    }
#pragma unroll
    for (int s = 0; s < 4; ++s) { const bf16x8 cf = *(const LAS bf16x8*)(Cs + (dir * 64 + 32 * eblk + c) * 72 + 16 * s + 8 * hh); acc2 = mfma32(cf, qf[s], acc2); }
    dsum += __shfl_xor(dsum, 32);
    const float eb = __expf(bct); const float den = dsum + eb * nq; const float rden = 1.0f / fmaxf(fabsf(den), 1.0f);
    if (dir == 0) {
#pragma unroll
        for (int i = 0; i < 16; ++i) Hs[t * 65 + 32 * eblk + (i & 3) + 8 * (i >> 2) + 4 * hh] = (acc[i] + eb * acc2[i]) * rden; }
    __syncthreads();
    if (dir == 1) {
#pragma unroll
        for (int i = 0; i < 16; ++i) Hs[t * 65 + 32 * eblk + (i & 3) + 8 * (i >> 2) + 4 * hh] += (acc[i] + eb * acc2[i]) * rden; }
    __syncthreads();
    { const int tt = C.tid >> 3, e0 = (C.tid & 7) * 8; float hv[8]; float ss = 0.f;
#pragma unroll
      for (int j = 0; j < 8; ++j) { hv[j] = Hs[tt * 65 + e0 + j]; ss += hv[j] * hv[j]; }
      ss += __shfl_xor(ss, 1); ss += __shfl_xor(ss, 2); ss += __shfl_xor(ss, 4);
      const float rs = 1.0f / sqrtf(ss * (1.0f / 64.0f) + NORM_EPS);
      bf16* rowp = z1 + (size_t)(r0 + tt) * ZP; const unsigned ow[4] = {R.ogate.x, R.ogate.y, R.ogate.z, R.ogate.w};
      const float ng[8] = {R.ng0[0], R.ng0[1], R.ng0[2], R.ng0[3], R.ng1[0], R.ng1[1], R.ng1[2], R.ng1[3]}; unsigned o[4];
#pragma unroll
      for (int q = 0; q < 4; ++q) o[q] = pk2(hv[2 * q] * rs * ng[2 * q] * sigmoidf_(bflo(ow[q])), hv[2 * q + 1] * rs * ng[2 * q + 1] * sigmoidf_(bfhi(ow[q])));
      u32x4 wv; wv.x = o[0]; wv.y = o[1]; wv.z = o[2]; wv.w = o[3];
      *(u32x4*)(rowp + 768 + h * 64 + e0) = wv; }
}
__device__ __forceinline__ void s5_carry_unit(const Ctx& C, int l, int unit) {
    const int x = unit * 512 + C.tid; const int p = x & 63, d = (x >> 6) & 1, g = (x >> 7) & 15, b = x >> 11;
    const float* lp = WSP(float, WS_LP) + ((((size_t)l * 2 + d) * 16 + g) * 64 + p) * 66; const float lr = lp[64], li = lp[65];
    const float* E = WSP(float, WS_E); bf16* A2 = WSP(bf16, WS_A2);
    float sr = 0.f; asm volatile("" : "+v"(sr)); float si = sr;
    size_t row[8], nrow[8]; float er[8], ei[8], ner[8], nei[8];
#define S5C_LOAD(S0, ROW, ER, EI) _Pragma("unroll") for (int k = 0; k < 8; ++k) { const int step = (S0) + k; const int ch = (S0) == 0 ? 2048 + b * 8 + (d == 0 ? step : 7 - step) : b * 256 + (d == 0 ? step - 8 : 263 - step); \
            ROW[k] = (size_t)g * NCH5P + ch; ER[k] = E[ROW[k] * 256 + (d * 2) * 64 + p]; EI[k] = E[ROW[k] * 256 + (d * 2 + 1) * 64 + p]; }
    S5C_LOAD(0, row, er, ei)
    for (int s0 = 0; s0 < 264; s0 += 8) {
        const int sn = s0 + 8 < 264 ? s0 + 8 : s0;
        S5C_LOAD(sn, nrow, ner, nei)
#pragma unroll
        for (int k = 0; k < 8; ++k) {
            A2[row[k] * A2P + 512 + (d * 2) * 64 + p] = f2bf(sr); A2[row[k] * A2P + 512 + (d * 2 + 1) * 64 + p] = f2bf(si);
            const float nr = lr * sr - li * si + er[k], ni = lr * si + li * sr + ei[k]; sr = nr; si = ni;
        }
#pragma unroll
        for (int k = 0; k < 8; ++k) { row[k] = nrow[k]; er[k] = ner[k]; ei[k] = nei[k]; }
    }
#undef S5C_LOAD
}

constexpr int PH_PER_LAYER = 15, PH_FINAL = 3 + 2 * PH_PER_LAYER, N_PHASES = PH_FINAL + 1;

__global__ void __launch_bounds__(512, 2) skel_fwd(Args args) {
    extern __shared__ __attribute__((aligned(16))) unsigned char lds_raw[];
    Ctx C; C.lds = (LAS unsigned char*)lds_raw; C.tid = threadIdx.x; C.lane = C.tid & 63; C.wave = __builtin_amdgcn_readfirstlane(C.tid >> 6); C.G = GRID; C.bid = blockIdx.x;
    C.ap = kargs();
    volatile LAS unsigned* MISC = (volatile LAS unsigned*)(C.lds + MISC_OFF);
    for (int u = C.tid; u < (LDS_BYTES - RING_BYTES) / 4; u += 512) ((LAS unsigned*)(C.lds + RING_BYTES))[u] = 0u;
    __syncthreads();
    if (C.ap->ph_hi - C.ap->ph_lo > 1) (void)xcd_barrier_post((unsigned*)(C.ap->ws + WS_CTL) + CW_BAR, MISC + 8);
#ifndef PHMASK
#define PHMASK 0xFFFFFFFFu
#endif
#define IN(k) (phase_enter(C) && C.ap->ph_lo <= (k) && (k) < C.ap->ph_hi)
#define EN(j) (((PHMASK) >> (j)) & 1u)
#ifndef DBLMASK
#define DBLMASK 0u
#endif
#define REPS(j) ((((DBLMASK) >> (j)) & 1u) ? 2 : 1)
#define SEAM(k) do { if ((k) + 1 < C.ap->ph_hi) { XcdBarrier bar_; bar_.bar = (unsigned*)(C.ap->ws + WS_CTL) + CW_BAR; bar_.x = xb_xcc_id(); bar_.st = (volatile LAS unsigned*)(C.lds + MISC_OFF) + 8; xcd_barrier(bar_); } } while (0)
#define ring (C.lds)
#define modl (WSP(float, WS_MODV) + (size_t)l * 9 * 6144)
#define xlat_in (l == 0 ? INP(0) : (const float*)OUTP)
#define xctx_in (l == 0 ? INP(2) : (const float*)WSP(float, WS_XC))
#define HN WSP(bf16, WS_HN)
#define Z1 WSP(bf16, WS_Z1)

    if (EN(16) && IN(0)) { for (int rep_ = 0; rep_ < REPS(16); ++rep_) pro0(C); SEAM(0); }
    if (EN(17) && IN(1)) { pro1(C); SEAM(1); }
    if (EN(18) && IN(2)) { pro2(C); norm_emit_phase(C, INP(0), INP(2), INP(6), WSP(float, WS_MODV), WSP(bf16, WS_HN), WSP(float, WS_SSQ), MTOT); SEAM(2); }

    for (int l = 0; l < DEPTH; ++l) {
        const int pb = 3 + l * PH_PER_LAYER;
        const int MP = l == 0 ? MTOT : MLAT;


        if (EN(1) && IN(pb + 1)) for (int rep_ = 0; rep_ < REPS(1); ++rep_) {
            pg8::Gemm g{HN, WSP(bf16, WS_WIN) + (size_t)l * NIN * 1024, MTOT, NIN, 1024, 1024, 1024}; PrefOrder S; S.init(MTOT, NIN, C.G, C.bid);
            S.ssq = WSP(float, WS_SSQ) + (size_t)(2 * l) * MTOT; S.shw = WSP(float, WS_SHWI) + (size_t)l * 9 * NIN; S.ldsh = NIN; S.slot = (LAS float*)(C.lds + PREF_OFF);
            EpiWin E{Z1, WSP(bf16, WS_A2), WSP(float, WS_GM), WSP(unsigned char, WS_GATE), (const LAS float*)(C.lds + PREF_OFF), INP(20) + l * 8, INP(21) + l * 8};
            pg8::gemm_phase<EpiWin, PrefOrder, true, true>(ring, g, S, E);
            SEAM(pb + 1);
        }
        if (EN(2) && IN(pb + 2)) for (int rep_ = 0; rep_ < REPS(2); ++rep_) {
            { pg8::Gemm g{WSP(bf16, WS_A2), WSP(bf16, WS_W1) + (size_t)l * 16 * 256 * 512, 16 * NCH5P, 16 * 256, 512, A2P, 512}; GroupOrder S{16, 9, 1, C.G, C.bid, 9};
              EpiS5E E{WSP(float, WS_E)};
              pg8::gemm_phase<EpiS5E, GroupOrder, true, true>(ring, g, S, E); }
            __syncthreads();
            asm volatile("" : "+v"(C.tid), "+v"(C.lane));
            for (int r2_ = 0; r2_ < REPS(12); ++r2_) {
                const int bid_ = C.bid;
                auto unit_of = [&](int k) -> int { if (bid_ >= 144) return k < 4 ? (bid_ - 144) + 112 * k : 448 + (GRID - 1 - bid_) + GRID * (k - 4); return 448 + (GRID - 1 - bid_) + GRID * k; };
                MlaIn cur, nxt; int k = 0, u = unit_of(0); { const int u0 = u < NCHM * 4 ? u : 0; mlA_load(C, u0 >> 2, u0 & 3, cur); }
                while (u < NCHM * 4) { const int un_ = unit_of(k + 1); const int un = un_ < NCHM * 4 ? un_ : u; mlA_load(C, un >> 2, un & 3, nxt); mlA_compute(C, l, u >> 2, u & 3, cur, k & 1); cur = nxt; u = un_; ++k; }
                __syncthreads(); }
            rope_phase(C);
            SEAM(pb + 2);
        }
        if (EN(3) && IN(pb + 3)) for (int rep_ = 0; rep_ < REPS(3); ++rep_) {
            const int natt = 2048 + (l == 0 ? 64 : 0);
            unsigned* qctr = (unsigned*)(C.ap->ws + WS_CTL) + 8192 + 64 * l;
            volatile LAS unsigned* qslot = (volatile LAS unsigned*)(C.lds + RING_BYTES + 64);
            unsigned qn = C.tid == 0 ? __hip_atomic_fetch_add(qctr, 1u, __ATOMIC_RELAXED, __HIP_MEMORY_SCOPE_AGENT) : 0u;
            for (;;) {
                __syncthreads();
                if (C.tid == 0) *qslot = qn;
                __syncthreads();
                const int u = (int)*qslot; if (u >= 96 + natt) break;
                if (C.tid == 0) qn = __hip_atomic_fetch_add(qctr, 1u, __ATOMIC_RELAXED, __HIP_MEMORY_SCOPE_AGENT);
                if (u < 32) s5_carry_unit(C, l, u);
                else if (u < 96) ml_carry_unit(C, u - 32);
                else { const int a = u - 96;
                    if (a < 2048) attn_unit(C, Z1, INP(9) + l * 8, a >> 8, (a >> 7) & 1, (a & 127) * 64, false);
                    else { const int cx = a - 2048; attn_unit(C, Z1, INP(9) + l * 8, cx >> 3, (cx >> 2) & 1, (cx & 3) * 64, true); } }
            }
            SEAM(pb + 3);
        }
        if (EN(4) && IN(pb + 4)) for (int rep_ = 0; rep_ < REPS(4); ++rep_) {
            { pg8::Gemm g{WSP(bf16, WS_A2), WSP(bf16, WS_W2) + (size_t)l * 16 * 512 * 768, 16 * NCH5P, 16 * 512, 768, A2P, 768}; GroupOrder S{16, l == 0 ? 9 : 8, 2, C.G, C.bid, 9};
              EpiS5Y E{WSP(bf16, WS_YPRE)};
              pg8::gemm_phase<EpiS5Y, GroupOrder, true, true>(ring, g, S, E); }
            __syncthreads();
            asm volatile("" : "+v"(C.tid), "+v"(C.lane));
            const int nml = (l == 0 ? NCHM : 1024) * 4;
            { const int R = l == 0 ? 6 : 0; const int bid_ = C.bid;
              auto unit_of = [&](int k) -> int { if (bid_ >= 32) return k < R ? (bid_ - 32) + 224 * k : R * 224 + (GRID - 1 - bid_) + GRID * (k - R); return R * 224 + (GRID - 1 - bid_) + GRID * k; };
              MlcIn cur, nxt; int k = 0, u = unit_of(0); { const int u0 = u < nml ? u : 0; mlC_load(C, l, u0 >> 2, u0 & 3, cur); }
              while (u < nml) { const int un_ = unit_of(k + 1); const int un = un_ < nml ? un_ : u; mlC_load(C, l, un >> 2, un & 3, nxt); mlC_compute(C, l, u >> 2, u & 3, cur, k & 1); cur = nxt; u = un_; ++k; } }
            SEAM(pb + 4);
        }
        if (EN(5) && IN(pb + 5)) for (int rep_ = 0; rep_ < REPS(5); ++rep_) {
            pg8::Gemm g{WSP(bf16, WS_YPRE), WSP(bf16, WS_WGLU) + (size_t)l * 256 * 256, MP, 256, 256, 256, 256}; pg8::StaticOrder S; S.init(MP, 256, C.G, C.bid);
            EpiGlu E{WSP(bf16, WS_YPRE), Z1 + 512, INP(19) + l * 256, ZP};
            pg8::gemm_phase<EpiGlu, pg8::StaticOrder, true, true>(ring, g, S, E);
            SEAM(pb + 5);
        }
        if (EN(6) && IN(pb + 6)) for (int rep_ = 0; rep_ < REPS(6); ++rep_) {
            pg8::Gemm g{Z1, WSP(bf16, WS_WBA) + (size_t)l * 1024 * 1024, MP, 1024, 1024, ZP, 1024}; pg8::StaticOrder S; S.init(MP, 2048, C.G, C.bid);
            EpiMergeF E{HN, WSP(unsigned char, WS_GATE)};
            pg8::gemm_phase<EpiMergeF, pg8::StaticOrder, true, true, true>(ring, g, S, E);
            SEAM(pb + 6);
        }
        if (EN(7) && IN(pb + 7)) for (int rep_ = 0; rep_ < REPS(7); ++rep_) {
            { pg8::Gemm g{HN, WSP(bf16, WS_WOUT) + (size_t)l * 1024 * 1024, MLAT, 1024, 1024, 1024, 1024}; pg8::StaticOrder S; S.init(MLAT, 1024, C.G, C.bid);
              EpiResid<true> E{xlat_in, xctx_in, OUTP, WSP(float, WS_XC), modl + 2048, 0, WSP(bf16, WS_HN2), WSP(float, WS_GAM) + (size_t)(l * 2 + 1) * 9 * 1024, WSP(float, WS_SSQ) + (size_t)(2 * l + 1) * MTOT};
              pg8::gemm_phase<EpiResid<true>, pg8::StaticOrder, true, true>(ring, g, S, E); }
            if (l == 0) {
                asm volatile("" : "+v"(C.tid), "+v"(C.lane));
                pg8::Gemm g{HN + (size_t)MLAT * 1024, WSP(bf16, WS_WOUT) + (size_t)l * 1024 * 1024, MCTX, 1024, 1024, 1024, 1024}; pg8::StaticOrder S; S.init(MCTX, 2048, C.G, C.bid);
                EpiResid<true, true> E{xlat_in, xctx_in, OUTP, WSP(float, WS_XC), modl + 2048, MLAT, WSP(bf16, WS_HN2), WSP(float, WS_GAM) + (size_t)(l * 2 + 1) * 9 * 1024, WSP(float, WS_SSQ) + (size_t)(2 * l + 1) * MTOT};
                pg8::gemm_phase<EpiResid<true, true>, pg8::StaticOrder, true, true, true>(ring, g, S, E); }
            SEAM(pb + 7);
        }
        if (EN(9) && IN(pb + 9)) {
            pg8::Gemm g{WSP(bf16, WS_HN2), WSP(bf16, WS_WUP) + (size_t)l * NUP * 1024, MP, NUP, 1024, 1024, 1024}; PrefOrder S; S.init(MP, NUP, C.G, C.bid);
            S.ssq = WSP(float, WS_SSQ) + (size_t)(2 * l + 1) * MTOT; S.shw = WSP(float, WS_SHWU) + (size_t)l * 9 * NUP; S.ldsh = NUP; S.slot = (LAS float*)(C.lds + PREF_OFF);
            EpiUpConv E{WSP(bf16, WS_ACT), WSP(float, WS_RAW), (const LAS float*)(C.lds + PREF_OFF), INP(28) + (size_t)l * 3 * NUP, INP(29) + (size_t)l * NUP, (LAS float*)(C.lds + RING_BYTES + 1024)};
            pg8::gemm_phase<EpiUpConv, PrefOrder, true, true>(ring, g, S, E);
            SEAM(pb + 9);
        }
        if (EN(10) && IN(pb + 10)) { seam_phase(C, WSP(float, WS_RAW), WSP(bf16, WS_ACT), INP(28) + (size_t)l * 3 * NUP, INP(29) + (size_t)l * NUP, MP / 256); SEAM(pb + 10); }
        if (EN(11) && IN(pb + 11)) {
            pg8::Gemm g{WSP(bf16, WS_ACT), WSP(bf16, WS_WDN) + (size_t)l * 1024 * DFF, MLAT, 1024, DFF, DFF, DFF}; pg8::StaticOrder S; S.init(MLAT, 1024, C.G, C.bid);
            if (l == 0) { { EpiResid<true> E{OUTP, WSP(float, WS_XC), OUTP, WSP(float, WS_XC), modl + 5120, 0, HN, WSP(float, WS_GAM) + (size_t)2 * 9 * 1024, WSP(float, WS_SSQ) + (size_t)2 * MTOT};
                  pg8::gemm_phase<EpiResid<true>, pg8::StaticOrder, true, true>(ring, g, S, E); }
                asm volatile("" : "+v"(C.tid), "+v"(C.lane));
                pg8::Gemm g2{WSP(bf16, WS_ACT) + (size_t)MLAT * DFF, WSP(bf16, WS_WDN) + (size_t)l * 1024 * DFF, MCTX, 1024, DFF, DFF, DFF}; pg8::StaticOrder S2; S2.init(MCTX, 2048, C.G, C.bid);
                EpiResid<true, true> E2{OUTP, WSP(float, WS_XC), OUTP, WSP(float, WS_XC), modl + 5120, MLAT, HN, WSP(float, WS_GAM) + (size_t)2 * 9 * 1024, WSP(float, WS_SSQ) + (size_t)2 * MTOT};
                pg8::gemm_phase<EpiResid<true, true>, pg8::StaticOrder, true, true, true>(ring, g2, S2, E2); }
            else { EpiResid<false> E{OUTP, WSP(float, WS_XC), OUTP, WSP(float, WS_XC), modl + 5120, 0, nullptr, nullptr, nullptr};
                pg8::gemm_phase<EpiResid<false>, pg8::StaticOrder, true, true>(ring, g, S, E); }
            SEAM(pb + 11);
        }
    }
    if (IN(PH_FINAL)) final_norm_phase(C, OUTP, INP(31));
#undef IN
#undef SEAM
#undef ring
#undef modl
#undef xlat_in
#undef xctx_in
#undef HN
#undef Z1
}


#ifndef MK_SPLIT
#define MK_SPLIT 0
#endif
extern "C" void kernel_launch(void* const* d_in, const int* in_sizes, int n_in, void* d_out, int out_size, void* d_ws, size_t ws_size, hipStream_t stream) {
    static int grid = 0;
    if (grid == 0) {
        if (n_in != 32 || out_size != MLAT * DM || ws_size < WS_END) { fprintf(stderr, "kernel_launch: unexpected problem (n_in %d, out %d, ws %zu, need %zu)\n", n_in, out_size, ws_size, (size_t)WS_END); grid = -1; return; }
        int dev = 0, cus = 0, per_cu = 0;
        if (hipGetDevice(&dev) != hipSuccess || hipDeviceGetAttribute(&cus, hipDeviceAttributeMultiprocessorCount, dev) != hipSuccess) { grid = -1; return; }
        if (hipFuncSetAttribute((const void*)skel_fwd, hipFuncAttributeMaxDynamicSharedMemorySize, LDS_BYTES) != hipSuccess) { fprintf(stderr, "kernel_launch: hipFuncSetAttribute failed\n"); grid = -1; return; }
        if (hipOccupancyMaxActiveBlocksPerMultiprocessor(&per_cu, (const void*)skel_fwd, 512, LDS_BYTES) != hipSuccess || per_cu < 1) fprintf(stderr, "kernel_launch: occupancy query reports %d\n", per_cu);
        (void)hipGetLastError();
        if (cus < GRID) { fprintf(stderr, "kernel_launch: built for a %d-CU device, found %d CUs\n", GRID, cus); grid = -1; return; }
        grid = GRID;
    }
    if (grid < 0) return;
    (void)hipMemsetAsync((char*)d_ws + WS_CTL, 0, ZERO_BYTES, stream);
    Args a{};
    for (int i = 0; i < 32; ++i) a.in[i] = (const float*)d_in[i];
    a.out = (float*)d_out; a.ws = (unsigned char*)d_ws;
#if MK_SPLIT
    for (int ph = 0; ph < N_PHASES; ++ph) { a.ph_lo = ph; a.ph_hi = ph + 1; hipLaunchKernelGGL(skel_fwd, dim3(grid), dim3(512), LDS_BYTES, stream, a); }
#else
    a.ph_lo = 0; a.ph_hi = N_PHASES; hipLaunchKernelGGL(skel_fwd, dim3(grid), dim3(512), LDS_BYTES, stream, a);
#endif
}
```
